# Optimizing an MI355X kernel written in HIP

```python
import jax
import jax.numpy as jnp
from jax import lax
import numpy as np

D_MODEL = 1024
BATCH = 32
SEQ = 2048
DEPTH = 2

CHUNK = 64
Q_BLOCK = 128
MEM_LEN = 256

MLA_HEADS = 8
QK_NOPE_DIM = 64
QK_ROPE_DIM = 32
V_HEAD_DIM = 64
Q_LORA_RANK = 256
KV_LORA_RANK = 256
MLA_WIDTH = MLA_HEADS * V_HEAD_DIM
CONV_WIDTH = D_MODEL - MLA_WIDTH
CONV_TAPS = 31
IN_COLS = Q_LORA_RANK + KV_LORA_RANK + QK_ROPE_DIM + 2 * CONV_WIDTH

XA_HEADS = 4
XA_HEAD_DIM = D_MODEL // XA_HEADS

FFN_HIDDEN = ((8 * D_MODEL + 3 * 256 - 1) // (3 * 256)) * 256

ALPHA = (2.0 * DEPTH) ** 0.25
BETA = (8.0 * DEPTH) ** -0.25

ROPE_BASE = 10000.0
LN_EPS = 1e-5
RMS_EPS = 1e-6

kernel_name = "hybrid_mla_conformer_deepnorm_encoder"


def layer_norm(x, g, b):
    xf = x.astype(jnp.float32)
    mu = jnp.mean(xf, axis=-1, keepdims=True)
    var = jnp.mean(jnp.square(xf - mu), axis=-1, keepdims=True)
    y = (xf - mu) * lax.rsqrt(var + LN_EPS)
    return (y * g.astype(jnp.float32) + b.astype(jnp.float32)).astype(x.dtype)


def rms_norm(x, g):
    xf = x.astype(jnp.float32)
    y = xf * lax.rsqrt(jnp.mean(jnp.square(xf), axis=-1, keepdims=True) + RMS_EPS)
    return (y * g.astype(jnp.float32)).astype(x.dtype)


def rope_cos_sin(positions, dim):
    inv_freq = ROPE_BASE ** (-jnp.arange(0, dim, 2, dtype=jnp.float32) / dim)
    ang = positions.astype(jnp.float32)[..., None] * inv_freq
    return jnp.cos(ang), jnp.sin(ang)


def apply_rope(x, cos, sin):
    half = x.shape[-1] // 2
    x1 = x[..., :half].astype(jnp.float32)
    x2 = x[..., half:].astype(jnp.float32)
    return jnp.concatenate([x1 * cos - x2 * sin, x1 * sin + x2 * cos], axis=-1).astype(x.dtype)


def mla_group(c_q, c_kv, k_r, cos, sin, q_norm_g, w_uq, kv_norm_g, w_ukv):
    B, S, _ = c_q.shape
    q = (rms_norm(c_q, q_norm_g) @ w_uq).reshape(B, S, MLA_HEADS, QK_NOPE_DIM + QK_ROPE_DIM)
    q_nope, q_rope = q[..., :QK_NOPE_DIM], q[..., QK_NOPE_DIM:]
    q_rope = apply_rope(q_rope, cos[:, :, None, :], sin[:, :, None, :])
    kv = (rms_norm(c_kv, kv_norm_g) @ w_ukv).reshape(B, S, MLA_HEADS, QK_NOPE_DIM + V_HEAD_DIM)
    k_nope, v = kv[..., :QK_NOPE_DIM], kv[..., QK_NOPE_DIM:]
    k_rope = apply_rope(k_r, cos, sin)
    scale = (QK_NOPE_DIM + QK_ROPE_DIM) ** -0.5
    outs = []
    for start in range(0, S, Q_BLOCK):
        end = start + Q_BLOCK
        s = (jnp.einsum('bqhd,bkhd->bhqk', q_nope[:, start:end], k_nope[:, :end])
             + jnp.einsum('bqhr,bkr->bhqk', q_rope[:, start:end], k_rope[:, :end]))
        q_chunk = jnp.arange(start, end) // CHUNK
        k_chunk = jnp.arange(end) // CHUNK
        mask = k_chunk[None, :] <= q_chunk[:, None]
        s = jnp.where(mask[None, None], s.astype(jnp.float32) * scale, -jnp.inf)
        p = jax.nn.softmax(s, axis=-1).astype(v.dtype)
        outs.append(jnp.einsum('bhqk,bkhd->bqhd', p, v[:, :end]))
    o = jnp.concatenate(outs, axis=1)
    return o.reshape(B, S, MLA_WIDTH)


def conformer_conv_group(u, dw_w, dw_b, norm_g, norm_b):
    a, g = jnp.split(u, 2, axis=-1)
    h = a * jax.nn.sigmoid(g)
    h = jnp.pad(h, ((0, 0), (CONV_TAPS - 1, 0), (0, 0)))
    h = lax.conv_general_dilated(
        h, dw_w[:, None, :], window_strides=(1,), padding='VALID',
        dimension_numbers=('NWC', 'WIO', 'NWC'), feature_group_count=CONV_WIDTH) + dw_b
    h = layer_norm(h, norm_g, norm_b)
    return jax.nn.silu(h)


def hybrid_mixer(x, cos, sin, w_in, b_in, q_norm_g, w_uq, kv_norm_g, w_ukv,
                 dw_w, dw_b, cn_g, cn_b, w_o):
    proj = x @ w_in + b_in
    o1 = Q_LORA_RANK
    o2 = o1 + KV_LORA_RANK
    o3 = o2 + QK_ROPE_DIM
    c_q, c_kv, k_r, u = proj[..., :o1], proj[..., o1:o2], proj[..., o2:o3], proj[..., o3:]
    y_att = mla_group(c_q, c_kv, k_r, cos, sin, q_norm_g, w_uq, kv_norm_g, w_ukv)
    y_conv = conformer_conv_group(u, dw_w, dw_b, cn_g, cn_b)
    return jnp.concatenate([y_att, y_conv], axis=-1) @ w_o


def memory_cross_attention(x, mem, w_q, w_kv, w_o):
    B, S, D = x.shape
    M = mem.shape[1]
    q = (x @ w_q).reshape(B, S, XA_HEADS, XA_HEAD_DIM)
    kv = (mem @ w_kv).reshape(B, M, 2, XA_HEADS, XA_HEAD_DIM)
    k, v = kv[:, :, 0], kv[:, :, 1]
    s = jnp.einsum('bshd,bmhd->bhsm', q, k).astype(jnp.float32) * (XA_HEAD_DIM ** -0.5)
    p = jax.nn.softmax(s, axis=-1).astype(v.dtype)
    o = jnp.einsum('bhsm,bmhd->bshd', p, v).reshape(B, S, D)
    return o @ w_o


def swiglu_ffn(x, w_in, w_down):
    gu = x @ w_in
    g, up = gu[..., :FFN_HIDDEN], gu[..., FFN_HIDDEN:]
    return (jax.nn.silu(g) * up) @ w_down


def setup_inputs(seed: int = 0) -> dict:
    key = jax.random.key(seed)
    ks = jax.random.split(key, 32)
    L, D = DEPTH, D_MODEL

    def normal(k, shape, fan_in, scale=1.0):
        return jax.random.normal(k, shape, jnp.float32) * (scale * fan_in ** -0.5)

    def gain(k, shape):
        return 1.0 + 0.02 * jax.random.normal(k, shape, jnp.float32)

    def small(k, shape):
        return 0.02 * jax.random.normal(k, shape, jnp.float32)

    x = jax.random.normal(ks[0], (BATCH, SEQ, D), jnp.float32)
    mem = jax.random.normal(ks[1], (BATCH, MEM_LEN, D), jnp.float32)
    offset = jax.random.randint(ks[2], (BATCH, 1), 0, 4096, dtype=jnp.int32)
    positions = offset + jnp.arange(SEQ, dtype=jnp.int32)[None, :]

    w_uk = normal(ks[7], (L, KV_LORA_RANK, MLA_HEADS, QK_NOPE_DIM), KV_LORA_RANK)
    w_uv = normal(ks[8], (L, KV_LORA_RANK, MLA_HEADS, V_HEAD_DIM), KV_LORA_RANK, BETA)
    mla_w_ukv = jnp.concatenate([w_uk, w_uv], axis=-1).reshape(
        L, KV_LORA_RANK, MLA_HEADS * (QK_NOPE_DIM + V_HEAD_DIM))
    xa_w_k = normal(ks[18], (L, D, D), D)
    xa_w_v = normal(ks[19], (L, D, D), D, BETA)
    xa_w_kv = jnp.concatenate([xa_w_k, xa_w_v], axis=-1)

    return {
        "x": x,
        "mem": mem,
        "positions": positions,
        "mix_w_in": normal(ks[3], (L, D, IN_COLS), D),
        "mix_b_in": small(ks[4], (L, IN_COLS)),
        "mla_q_norm": gain(ks[5], (L, Q_LORA_RANK)),
        "mla_w_uq": normal(ks[6], (L, Q_LORA_RANK, MLA_HEADS * (QK_NOPE_DIM + QK_ROPE_DIM)), Q_LORA_RANK),
        "mla_kv_norm": gain(ks[9], (L, KV_LORA_RANK)),
        "mla_w_ukv": mla_w_ukv,
        "conv_dw_w": normal(ks[10], (L, CONV_TAPS, CONV_WIDTH), CONV_TAPS),
        "conv_dw_b": small(ks[11], (L, CONV_WIDTH)),
        "conv_norm_g": gain(ks[12], (L, CONV_WIDTH)),
        "conv_norm_b": small(ks[13], (L, CONV_WIDTH)),
        "mix_w_o": normal(ks[14], (L, D, D), D, BETA),
        "ln1_g": gain(ks[15], (L, D)),
        "ln1_b": small(ks[16], (L, D)),
        "xa_w_q": normal(ks[17], (L, D, D), D),
        "xa_w_kv": xa_w_kv,
        "xa_w_o": normal(ks[20], (L, D, D), D, BETA),
        "ln2_g": gain(ks[21], (L, D)),
        "ln2_b": small(ks[22], (L, D)),
        "ffn_w_in": normal(ks[23], (L, D, 2 * FFN_HIDDEN), D),
        "ffn_w_down": normal(ks[24], (L, FFN_HIDDEN, D), FFN_HIDDEN, BETA),
        "ln3_g": gain(ks[25], (L, D)),
        "ln3_b": small(ks[26], (L, D)),
    }


def reference(x, mem, positions, mix_w_in, mix_b_in, mla_q_norm, mla_w_uq, mla_kv_norm,
              mla_w_ukv, conv_dw_w, conv_dw_b, conv_norm_g, conv_norm_b, mix_w_o,
              ln1_g, ln1_b, xa_w_q, xa_w_kv, xa_w_o, ln2_g, ln2_b,
              ffn_w_in, ffn_w_down, ln3_g, ln3_b):
    cos, sin = rope_cos_sin(positions, QK_ROPE_DIM)
    for l in range(DEPTH):
        y = hybrid_mixer(x, cos, sin, mix_w_in[l], mix_b_in[l], mla_q_norm[l], mla_w_uq[l],
                         mla_kv_norm[l], mla_w_ukv[l], conv_dw_w[l], conv_dw_b[l],
                         conv_norm_g[l], conv_norm_b[l], mix_w_o[l])
        x = layer_norm(ALPHA * x + y, ln1_g[l], ln1_b[l])
        y = memory_cross_attention(x, mem, xa_w_q[l], xa_w_kv[l], xa_w_o[l])
        x = layer_norm(ALPHA * x + y, ln2_g[l], ln2_b[l])
        y = swiglu_ffn(x, ffn_w_in[l], ffn_w_down[l])
        x = layer_norm(ALPHA * x + y, ln3_g[l], ln3_b[l])
    return x
```

```cpp
#include <hip/hip_runtime.h>
#include <hip/hip_cooperative_groups.h>
#include <cstdio>
#include <cstdint>
namespace cg = cooperative_groups;

#define LAS __attribute__((address_space(3)))
typedef _Float16 h16;
typedef _Float16 h16x8 __attribute__((ext_vector_type(8)));
typedef _Float16 h16x4 __attribute__((ext_vector_type(4)));
typedef _Float16 h16x2 __attribute__((ext_vector_type(2)));
typedef float f32x4 __attribute__((ext_vector_type(4)));
typedef float f32x2 __attribute__((ext_vector_type(2)));
typedef float f32x16 __attribute__((ext_vector_type(16)));
typedef unsigned u32x4 __attribute__((ext_vector_type(4)));

constexpr int TT = 65536, DM = 1024, SEQ = 2048, NB = 32, MEMT = 8192, FFH = 2816;
constexpr int PROJW = 1536;
constexpr float ALPHA = 1.4142135623730951f;
constexpr float QSCALE = 0.14724444602590306f;
constexpr float XQSCALE = 0.09016844005556021f;
constexpr size_t MiB = 1u << 20;
constexpr size_t WS_BIAS = 0;
constexpr size_t WS_W = 1 * MiB;
constexpr size_t WS_COS = 65 * MiB, WS_SIN = 69 * MiB, WS_SSQ = 73 * MiB;
constexpr size_t WS_MEMH = 76 * MiB, WS_XK = 92 * MiB, WS_XVT = 124 * MiB;
constexpr size_t WS_XH = 156 * MiB, WS_YCAT = 284 * MiB, WS_VT = 412 * MiB, WS_KR = 476 * MiB, WS_BIG = 480 * MiB;
constexpr size_t WS_PROJ = WS_BIG, WS_Q = WS_BIG + 224 * MiB, WS_KN = WS_BIG + 320 * MiB;
constexpr size_t WS_XQ = WS_BIG, WS_P = WS_BIG + 128 * MiB, WS_XO = WS_BIG + 256 * MiB, WS_H = WS_BIG;
constexpr size_t WS_PART = 864 * MiB;
constexpr size_t WS_CSBW = 867 * MiB;
constexpr size_t WS_ST = 868 * MiB;
constexpr size_t WS_END = 872 * MiB;
constexpr int NCS = 1792 + 1024 + 5632;
constexpr size_t WO_WIN = 0, WO_WUQ = WO_WIN + 1792 * 1024, WO_WUK = WO_WUQ + 768 * 256, WO_WUV = WO_WUK + 512 * 256,
                 WO_WO = WO_WUV + 512 * 256, WO_XWQ = WO_WO + 1024 * 1024, WO_XWKV = WO_XWQ + 1024 * 1024,
                 WO_XWO = WO_XWKV + 2048 * 1024, WO_FWIN = WO_XWO + 1024 * 1024, WO_FWD = WO_FWIN + 5632 * 1024,
                 WO_END = WO_FWD + 1024 * 2816;
static_assert(WO_END * 2 <= 32 * MiB, "weights per layer");
constexpr int LDS_STATS = 131072 + 8192 + 1024 + 64;
constexpr int LDS_COLS = LDS_STATS + 2 * 8192;
constexpr int LDS_BYTES = LDS_COLS + 2 * 2048;
constexpr size_t WS_BAR = 256 * 1024;

struct Params {
    const float* in[25];
    const int* pos;
    float* out;
    unsigned char* ws;
};

typedef const __attribute__((address_space(4))) Params* KP;
__device__ __forceinline__ KP kparams() { KP p = (KP)__builtin_amdgcn_kernarg_segment_ptr(); asm volatile("" : "+s"(p)); return p; }

__device__ __forceinline__ int tid_here() { int t = threadIdx.x; asm volatile("" : "+v"(t)); return t; }
__device__ __forceinline__ int bid_here() { int b = blockIdx.x; asm volatile("" : "+s"(b)); return b; }

__device__ __forceinline__ float wave_sum(float v) {
#pragma unroll
    for (int o = 1; o < 64; o <<= 1) v += __shfl_xor(v, o);
    return v;
}
__device__ __forceinline__ h16x4 cvt4(f32x4 v) { h16x4 r; r[0] = (h16)v[0]; r[1] = (h16)v[1]; r[2] = (h16)v[2]; r[3] = (h16)v[3]; return r; }
__device__ __forceinline__ float fast_exp2(float x) { return __builtin_amdgcn_exp2f(x); }

constexpr int BM = 256, BK = 64, HALF = 128, HTB = HALF * BK * 2, NXCD = 8, WGM = 8;
__device__ __forceinline__ int lds_byte(int r, int c) { const int st = (r >> 4) * 2 + (c >> 5), rr = r & 15, cc = c & 31, ob = rr * 64 + cc * 2; return st * 1024 + (ob ^ (((ob >> 9) & 1) << 5)); }
__device__ __forceinline__ void stage_rc(int b, int& R, int& C) { const int st = b / 1024, sb = b % 1024, swz = sb ^ (((sb >> 9) & 1) << 5); R = (st >> 1) * 16 + swz / 64; C = (st & 1) * 32 + (swz % 64) / 2; }

__device__ __forceinline__ int perm32(int rho) { const int n = rho >> 4, i = rho & 15; return 8 * (i >> 2) + 4 * n + (i & 3); }
enum { E_INPROJ = 0, E_QUP, E_KUP, E_VTUP, E_F16, E_RESID, E_SOFTMAX, E_SWIGLU, E_RESID0 };
struct GemmDesc {
    const h16* A; const h16* B; int lda, ldb, K;
    int nM, nN, nZ1, nZ2;
    int a_s1, a_s2, b_s1, b_s2;
    int epi;
    void* out; int ldc; float scale; const float* res; const float* bias;
    const float* st_in; float* st_out; const float* cs; int fold;
};
struct Unit { int row0, col0, pn; unsigned a, b; };

__device__ __forceinline__ bool unit_next(const GemmDesc& g, int i, int G, int c, Unit& u) {
    const int nwg = g.nZ1 * g.nZ2 * g.nM * g.nN;
    const long L = (long)i * G + c; if (L >= nwg) return false;
    int zb = 0, zh = 0, pm, pn;
    if (g.nZ1 * g.nZ2 == 1) {
        const int nM = g.nM, nN = g.nN;
        int wgid = (int)L; { const int q = nwg / NXCD, r = nwg % NXCD, xcd = wgid % NXCD, off = wgid / NXCD; wgid = (xcd < r ? xcd * (q + 1) : r * (q + 1) + (xcd - r) * q) + off; }
        const int nig = WGM * nN, gid = wgid / nig, fm = gid * WGM, gsz = (nM - fm) < WGM ? (nM - fm) : WGM;
        pm = fm + ((wgid % nig) % gsz); pn = (wgid % nig) / gsz;
    } else {
        int r = (int)L; pn = r % g.nN; r /= g.nN; pm = r % g.nM; r /= g.nM; zh = r % g.nZ2; zb = r / g.nZ2;
    }
    u.row0 = (zb * g.nM + pm) * BM; u.col0 = (zh * g.nN + pn) * BM; u.pn = pn;
    u.a = (unsigned)(zb * g.a_s1 + zh * g.a_s2 + pm * BM * g.lda) * 2u;
    u.b = (unsigned)(zb * g.b_s1 + zh * g.b_s2 + pn * BM * g.ldb) * 2u;
    return true;
}

__device__ __forceinline__ void row_stats(const LAS float* st, int row, float& mu, float& rstd) {
    const f32x4 a = *(const LAS f32x4*)(st + row * 8), b = *(const LAS f32x4*)(st + row * 8 + 4);
    mu = ((a[0] + a[2]) + (b[0] + b[2])) * (1.f / DM);
    const float var = ((a[1] + a[3]) + (b[1] + b[3])) * (1.f / DM) - mu * mu;
    rstd = __builtin_amdgcn_rsqf(var + 1e-5f);
}
template <int CN> __device__ __forceinline__ void fold_acc(f32x4 (&acc)[2][2][4][2], const LAS float* stl, const LAS float* ctl, int rloc, int cloc) {
    f32x4 cs[2][2], bw[2][2];
#pragma unroll
    for (int bj = 0; bj < 2; ++bj)
#pragma unroll
        for (int n = 0; n < 2; ++n) { cs[bj][n] = *(const LAS f32x4*)(ctl + cloc + bj * HALF + n * CN); bw[bj][n] = *(const LAS f32x4*)(ctl + 256 + cloc + bj * HALF + n * CN); }
#pragma unroll
    for (int ai = 0; ai < 2; ++ai)
#pragma unroll
        for (int m = 0; m < 4; ++m) { float mu, rstd; row_stats(stl, rloc + ai * HALF + m * 16, mu, rstd);
#pragma unroll
            for (int bj = 0; bj < 2; ++bj)
#pragma unroll
                for (int n = 0; n < 2; ++n) acc[ai][bj][m][n] = (acc[ai][bj][m][n] - cs[bj][n] * mu) * rstd + bw[bj][n]; }
}

#define LDS_BARRIER() asm volatile("s_waitcnt lgkmcnt(0)\n\ts_barrier" ::: "memory")
template <int EPI> __device__ __forceinline__ void epilogue(const GemmDesc& g, const Unit& u, f32x4 (&acc)[2][2][4][2], int wr, int wc, int fr, int fq,
                                         LAS unsigned char* lds, unsigned char* ws, const LAS float* stl, const LAS float* ctl) {
    const float* COS = (const float*)(ws + WS_COS); const float* SIN = (const float*)(ws + WS_SIN); float* SSQ = (float*)(ws + WS_SSQ);
    const int rbase = u.row0 + wr * 64 + fr;
    constexpr int CN = 4;
    const int cbase = u.col0 + wc * 32 + 8 * fq;
    if (EPI == E_INPROJ || EPI == E_F16 || EPI == E_SWIGLU) { if (g.fold) fold_acc<CN>(acc, stl, ctl, wr * 64 + fr, cbase - u.col0); }
    switch (EPI) {
    case E_INPROJ: {
        if (u.pn < 6) {
            h16* O = (h16*)g.out;
            f32x4 bv[2][2];
#pragma unroll
            for (int bj = 0; bj < 2; ++bj)
#pragma unroll
                for (int n = 0; n < 2; ++n) bv[bj][n] = *(const f32x4*)(g.bias + cbase + bj * HALF + n * CN);
#pragma unroll
            for (int ai = 0; ai < 2; ++ai)
#pragma unroll
                for (int m = 0; m < 4; ++m) {
                    const int row = rbase + ai * HALF + m * 16; float ss = 0.f;
#pragma unroll
                    for (int bj = 0; bj < 2; ++bj)
#pragma unroll
                        for (int n = 0; n < 2; ++n) { const f32x4 v = acc[ai][bj][m][n] + bv[bj][n]; ss += (v[0] * v[0] + v[1] * v[1]) + (v[2] * v[2] + v[3] * v[3]);
                            *(h16x4*)(O + (size_t)row * PROJW + cbase + bj * HALF + n * CN) = cvt4(v); }
                    if (u.pn < 2) { ss += __shfl_xor(ss, 16); ss += __shfl_xor(ss, 32); if (fq == 0) SSQ[(size_t)row * 8 + u.pn * 4 + wc] = ss; }
                }
        } else if (wc == 0) {
            h16* KR = (h16*)(ws + WS_KR);
            const f32x4 b0 = *(const f32x4*)(g.bias + 1536 + 4 * fq), b1 = *(const f32x4*)(g.bias + 1536 + 16 + 4 * fq);
#pragma unroll
            for (int ai = 0; ai < 2; ++ai)
#pragma unroll
                for (int m = 0; m < 4; ++m) {
                    const int row = rbase + ai * HALF + m * 16;
                    const f32x4 c = *(const f32x4*)(COS + (size_t)row * 16 + 4 * fq), s = *(const f32x4*)(SIN + (size_t)row * 16 + 4 * fq);
                    const f32x4 v0 = acc[ai][0][m][0] + b0, v1 = acc[ai][0][m][1] + b1;
                    *(h16x4*)(KR + (size_t)row * 32 + 4 * fq) = cvt4(v0 * c - v1 * s);
                    *(h16x4*)(KR + (size_t)row * 32 + 16 + 4 * fq) = cvt4(v0 * s + v1 * c);
                }
        }
    } break;
    case E_QUP: {
        h16* O = (h16*)g.out;
#pragma unroll
        for (int ai = 0; ai < 2; ++ai) {
            float scr_[4]; f32x4 cr[4], sr[4];
#pragma unroll
            for (int m = 0; m < 4; ++m) { const int row = rbase + ai * HALF + m * 16;
                const f32x4 q4 = *(const LAS f32x4*)(stl + (row - u.row0) * 8);
                scr_[m] = QSCALE * __builtin_amdgcn_rsqf(((q4[0] + q4[1]) + (q4[2] + q4[3])) * (1.f / 256.f) + 1e-6f);
                cr[m] = *(const f32x4*)(COS + (size_t)row * 16 + 4 * fq); sr[m] = *(const f32x4*)(SIN + (size_t)row * 16 + 4 * fq); }
#pragma unroll
            for (int m = 0; m < 4; ++m) {
                const int row = rbase + ai * HALF + m * 16;
                const float sc = scr_[m]; const f32x4 c = cr[m], s = sr[m];
#pragma unroll
                for (int bj = 0; bj < 2; ++bj) {
                    const int gcol = u.col0 + bj * HALF + wc * 32;
                    const f32x4 v0 = acc[ai][bj][m][0] * sc, v1 = acc[ai][bj][m][1] * sc;
                    if ((gcol >> 5) % 3 == 2) {
                        *(h16x4*)(O + (size_t)row * 768 + gcol + 4 * fq) = cvt4(v0 * c - v1 * s);
                        *(h16x4*)(O + (size_t)row * 768 + gcol + 16 + 4 * fq) = cvt4(v0 * s + v1 * c);
                    } else {
                        *(h16x4*)(O + (size_t)row * 768 + gcol + 8 * fq) = cvt4(v0);
                        *(h16x4*)(O + (size_t)row * 768 + gcol + 8 * fq + 4) = cvt4(v1);
                    }
                }
            }
        }
    } break;
    case E_KUP: {
        h16* O = (h16*)g.out;
        float scr_[2][4];
#pragma unroll
        for (int ai = 0; ai < 2; ++ai)
#pragma unroll
            for (int m = 0; m < 4; ++m) { const f32x4 q4 = *(const LAS f32x4*)(stl + (rbase - u.row0 + ai * HALF + m * 16) * 8 + 4);
                scr_[ai][m] = __builtin_amdgcn_rsqf(((q4[0] + q4[1]) + (q4[2] + q4[3])) * (1.f / 256.f) + 1e-6f); }
#pragma unroll
        for (int ai = 0; ai < 2; ++ai)
#pragma unroll
            for (int m = 0; m < 4; ++m) {
                const int row = rbase + ai * HALF + m * 16; const float sc = scr_[ai][m];
#pragma unroll
                for (int bj = 0; bj < 2; ++bj)
#pragma unroll
                    for (int n = 0; n < 2; ++n) *(h16x4*)(O + (size_t)row * 512 + cbase + bj * HALF + n * CN) = cvt4(acc[ai][bj][m][n] * sc);
            }
    } break;
    case E_VTUP: {
        h16* O = (h16*)g.out;
        f32x4 sc[2][2];
#pragma unroll
        for (int bj = 0; bj < 2; ++bj)
#pragma unroll
            for (int n = 0; n < 2; ++n)
#pragma unroll
                for (int j = 0; j < 4; ++j) { const f32x4 q4 = *(const LAS f32x4*)(stl + (cbase - u.col0 + bj * HALF + n * CN + j) * 8 + 4);
                    sc[bj][n][j] = __builtin_amdgcn_rsqf(((q4[0] + q4[1]) + (q4[2] + q4[3])) * (1.f / 256.f) + 1e-6f); }
#pragma unroll
        for (int ai = 0; ai < 2; ++ai)
#pragma unroll
            for (int m = 0; m < 4; ++m) {
                const int row = rbase + ai * HALF + m * 16;
#pragma unroll
                for (int bj = 0; bj < 2; ++bj)
#pragma unroll
                    for (int n = 0; n < 2; ++n) *(h16x4*)(O + (size_t)row * TT + cbase + bj * HALF + n * CN) = cvt4(acc[ai][bj][m][n] * sc[bj][n]);
            }
    } break;
    case E_F16: {
        h16* O = (h16*)g.out; const float sc = g.scale; const int ldc = g.ldc;
#pragma unroll
        for (int ai = 0; ai < 2; ++ai)
#pragma unroll
            for (int m = 0; m < 4; ++m) {
                const int row = rbase + ai * HALF + m * 16;
#pragma unroll
                for (int bj = 0; bj < 2; ++bj)
#pragma unroll
                    for (int n = 0; n < 2; ++n) *(h16x4*)(O + (size_t)row * ldc + cbase + bj * HALF + n * CN) = cvt4(acc[ai][bj][m][n] * sc);
            }
    } break;
    case E_RESID0:
    case E_RESID: {
        constexpr bool FOLD = (EPI == E_RESID);
        const h16* ZH = (const h16*)(ws + WS_XH); h16* ZO = (h16*)g.out;
        LAS f32x2* PP = (LAS f32x2*)(lds + 131072);
#define RS_LOAD(ZB, XB, ai_, m0_) do { _Pragma("unroll") for (int mm = 0; mm < 2; ++mm) { const size_t off_ = (size_t)(rbase + (ai_) * HALF + ((m0_) + mm) * 16) * DM + cbase; \
            _Pragma("unroll") for (int bj = 0; bj < 2; ++bj) { if (FOLD) ZB[mm][bj] = *(const h16x8*)(ZH + off_ + bj * HALF); \
                else { XB[mm][bj][0] = *(const f32x4*)(g.res + off_ + bj * HALF); XB[mm][bj][1] = *(const f32x4*)(g.res + off_ + bj * HALF + 4); } } } } while (0)
#define RS_PROC(ZB, XB, ai_, m0_) do { _Pragma("unroll") for (int mm = 0; mm < 2; ++mm) { const int m = (m0_) + mm; \
            const int row = rbase + (ai_) * HALF + m * 16; const size_t off = (size_t)row * DM + cbase; \
            float mu_ = 0.f, rstd_ = 1.f; if (FOLD) row_stats(stl, row - u.row0, mu_, rstd_); \
            const LAS float* ctr = ctl + (cbase - u.col0); asm volatile("" : "+v"(ctr)); \
            float ps = 0.f, pss = 0.f; \
            _Pragma("unroll") for (int bj = 0; bj < 2; ++bj) { h16x8 zo; \
                _Pragma("unroll") for (int n = 0; n < 2; ++n) { f32x4 x; \
                    if (FOLD) { const f32x4 gvv = *(const LAS f32x4*)(ctr + bj * HALF + n * CN), bvv = *(const LAS f32x4*)(ctr + 256 + bj * HALF + n * CN); \
                        _Pragma("unroll") for (int j = 0; j < 4; ++j) x[j] = ((float)ZB[mm][bj][4 * n + j] - mu_) * rstd_ * gvv[j] + bvv[j]; } \
                    else x = XB[mm][bj][n]; \
                    const f32x4 z = x * ALPHA + acc[ai_][bj][m][n]; \
                    ps += (z[0] + z[1]) + (z[2] + z[3]); pss += (z[0] * z[0] + z[1] * z[1]) + (z[2] * z[2] + z[3] * z[3]); \
                    _Pragma("unroll") for (int j = 0; j < 4; ++j) zo[4 * n + j] = (h16)z[j]; } \
                *(h16x8*)(ZO + off + bj * HALF) = zo; } \
            ps += __shfl_xor(ps, 16); ps += __shfl_xor(ps, 32); pss += __shfl_xor(pss, 16); pss += __shfl_xor(pss, 32); \
            if (fq == 0) PP[((ai_) * HALF + wr * 64 + m * 16 + fr) * 4 + wc] = (f32x2){ps, pss}; } } while (0)
        if (FOLD) {
            h16x8 zA[2][2], zB[2][2]; f32x4 xd[2][2][2];
            RS_LOAD(zA, xd, 0, 0); RS_LOAD(zB, xd, 0, 2);
            RS_PROC(zA, xd, 0, 0); RS_LOAD(zA, xd, 1, 0);
            RS_PROC(zB, xd, 0, 2); RS_LOAD(zB, xd, 1, 2);
            RS_PROC(zA, xd, 1, 0);
            RS_PROC(zB, xd, 1, 2);
        } else {
            h16x8 zd[2][2]; f32x4 xA[2][2][2];
#pragma unroll
            for (int ai = 0; ai < 2; ++ai)
#pragma unroll
                for (int m0 = 0; m0 < 4; m0 += 2) { RS_LOAD(zd, xA, ai, m0); RS_PROC(zd, xA, ai, m0); }
        }
#undef RS_LOAD
#undef RS_PROC
        LDS_BARRIER();
        { const int t = wr * 256 + wc * 64 + fq * 16 + fr;
          if (t < 256) { const f32x2 a = PP[t * 4 + 0], b = PP[t * 4 + 1], c = PP[t * 4 + 2], d = PP[t * 4 + 3];
              *(f32x2*)(g.st_out + (size_t)(u.row0 + t) * 8 + u.pn * 2) = (f32x2){(a[0] + b[0]) + (c[0] + d[0]), (a[1] + b[1]) + (c[1] + d[1])}; } }
    } break;
    case E_SOFTMAX: {
        h16* O = (h16*)g.out;
        LAS float* PM = (LAS float*)(lds + 131072);
        LAS float* PS = (LAS float*)(lds + 131072 + 4096);
        float mx[2][4];
#pragma unroll
        for (int ai = 0; ai < 2; ++ai)
#pragma unroll
            for (int m = 0; m < 4; ++m) {
                float v = -INFINITY;
#pragma unroll
                for (int bj = 0; bj < 2; ++bj)
#pragma unroll
                    for (int n = 0; n < 2; ++n) { const f32x4 x = acc[ai][bj][m][n]; v = fmaxf(v, fmaxf(fmaxf(x[0], x[1]), fmaxf(x[2], x[3]))); }
                v = fmaxf(v, __shfl_xor(v, 16)); v = fmaxf(v, __shfl_xor(v, 32));
                if (fq == 0) PM[(ai * HALF + wr * 64 + m * 16 + fr) * 4 + wc] = v;
            }
        LDS_BARRIER();
#pragma unroll
        for (int ai = 0; ai < 2; ++ai)
#pragma unroll
            for (int m = 0; m < 4; ++m) {
                const f32x4 p = *(const LAS f32x4*)(PM + (ai * HALF + wr * 64 + m * 16 + fr) * 4);
                const float mm = fmaxf(fmaxf(p[0], p[1]), fmaxf(p[2], p[3])); mx[ai][m] = mm; float s = 0.f;
#pragma unroll
                for (int bj = 0; bj < 2; ++bj)
#pragma unroll
                    for (int n = 0; n < 2; ++n) { f32x4 x = acc[ai][bj][m][n];
#pragma unroll
                        for (int j = 0; j < 4; ++j) { x[j] = fast_exp2(x[j] - mm); s += x[j]; }
                        acc[ai][bj][m][n] = x; }
                s += __shfl_xor(s, 16); s += __shfl_xor(s, 32);
                if (fq == 0) PS[(ai * HALF + wr * 64 + m * 16 + fr) * 4 + wc] = s;
            }
        LDS_BARRIER();
#pragma unroll
        for (int ai = 0; ai < 2; ++ai)
#pragma unroll
            for (int m = 0; m < 4; ++m) {
                const f32x4 p = *(const LAS f32x4*)(PS + (ai * HALF + wr * 64 + m * 16 + fr) * 4);
                const float inv = 1.f / ((p[0] + p[1]) + (p[2] + p[3]));
                const int row = rbase + ai * HALF + m * 16;
#pragma unroll
                for (int bj = 0; bj < 2; ++bj)
#pragma unroll
                    for (int n = 0; n < 2; ++n) *(h16x4*)(O + (size_t)row * DM + cbase + bj * HALF + n * CN) = cvt4(acc[ai][bj][m][n] * inv);
            }
        (void)mx;
    } break;
    case E_SWIGLU: {
        h16* O = (h16*)g.out;
#pragma unroll
        for (int ai = 0; ai < 2; ++ai)
#pragma unroll
            for (int m = 0; m < 4; ++m) {
                const int row = rbase + ai * HALF + m * 16;
#pragma unroll
                for (int n = 0; n < 2; ++n) { const f32x4 gt = acc[ai][0][m][n], up = acc[ai][1][m][n]; f32x4 hv;
#pragma unroll
                    for (int j = 0; j < 4; ++j) hv[j] = gt[j] * __builtin_amdgcn_rcpf(1.f + fast_exp2(gt[j] * -1.4426950408889634f)) * up[j];
                    *(h16x4*)(O + (size_t)row * FFH + u.pn * HALF + (cbase - u.col0) + n * CN) = cvt4(hv); }
            }
    } break;
    default: break;
    }
}

template <int EPI> __device__ __forceinline__ void gemm_run(LAS unsigned char* lds, const GemmDesc& g, unsigned char* ws) {
    const int tid = tid_here(), wid = __builtin_amdgcn_readfirstlane(tid >> 6), lane = tid & 63, wr = wid >> 2, wc = wid & 3, fr = lane & 15, fq = lane >> 4;
    LAS int* utab = (LAS int*)(lds + 131072 + 8192);
    if (tid < 32) { Unit u; const bool ok = unit_next(g, tid, gridDim.x, bid_here(), u);
        utab[tid * 8 + 0] = ok ? u.row0 : -1; utab[tid * 8 + 1] = u.col0; utab[tid * 8 + 2] = u.pn; utab[tid * 8 + 3] = (int)u.a; utab[tid * 8 + 4] = (int)u.b; }
    __syncthreads();
#define UT(i, f) __builtin_amdgcn_readfirstlane(utab[(i) * 8 + (f)])
    const int nt = g.K / BK;
    const char* const gA = (const char*)g.A; const char* const gB = (const char*)g.B;
    unsigned voffA[2], voffB[2];
#pragma unroll
    for (int i = 0; i < 2; ++i) { int R, C; stage_rc(tid * 16 + i * 8192, R, C); const int Rb = (R & ~31) + perm32(R & 31);
        voffA[i] = (unsigned)(R * g.lda + C) * 2u; voffB[i] = (unsigned)(Rb * g.ldb + C) * 2u; }
    const unsigned kstep = (unsigned)(BK * 2);
    const unsigned hstepA = (unsigned)HALF * g.lda * 2u, hstepB = (unsigned)HALF * g.ldb * 2u;
    const unsigned ldsw = (unsigned)wid * 1024u;
    const int aoff = lds_byte(wr * 64 + fr, fq * 8), boff = lds_byte(wc * 32 + fr, fq * 8);
#define SA(b, h) (((b) * 2 + (h)) * HTB)
#define SB(b, h) ((4 + (b) * 2 + (h)) * HTB)
#define STAGE(bufoff, gbase, soff, voff) do { _Pragma("unroll") for (int _i = 0; _i < 2; ++_i) \
        __builtin_amdgcn_global_load_lds((const unsigned*)((gbase) + (size_t)((soff) + (voff)[_i])), (LAS unsigned*)(lds + (bufoff) + ldsw + _i * 8192), 16, 0, 0); } while (0)
#define LDA(dst, b, h) do { _Pragma("unroll") for (int m = 0; m < 4; ++m) _Pragma("unroll") for (int k = 0; k < 2; ++k) dst[m][k] = *(const LAS h16x8*)(lds + SA(b, h) + aoff + m * 2048 + k * 1024); } while (0)
#define LDB(dst, b, h) do { _Pragma("unroll") for (int n = 0; n < 2; ++n) _Pragma("unroll") for (int k = 0; k < 2; ++k) dst[n][k] = *(const LAS h16x8*)(lds + SB(b, h) + boff + n * 2048 + k * 1024); } while (0)
#define MMA(ai, bj, At, Bt) do { __builtin_amdgcn_s_setprio(1); _Pragma("unroll") for (int m = 0; m < 4; ++m) _Pragma("unroll") for (int n = 0; n < 2; ++n) _Pragma("unroll") for (int k = 0; k < 2; ++k) \
        acc[ai][bj][m][n] = __builtin_amdgcn_mfma_f32_16x16x32_f16(Bt[n][k], At[m][k], acc[ai][bj][m][n], 0, 0, 0); __builtin_amdgcn_s_setprio(0); } while (0)
#define WAIT_V(n) asm volatile("s_waitcnt vmcnt(" #n ")" ::: "memory")
#define WAIT_L(n) asm volatile("s_waitcnt lgkmcnt(" #n ")" ::: "memory")
#define BAR __builtin_amdgcn_s_barrier()
#define SCHED __builtin_amdgcn_sched_barrier(0)
    Unit cur; int ui = 0;
    cur.row0 = UT(0, 0);
    if (cur.row0 < 0) return;
    cur.col0 = UT(0, 1); cur.pn = UT(0, 2); cur.a = (unsigned)UT(0, 3); cur.b = (unsigned)UT(0, 4);
    f32x4 acc[2][2][4][2];
#pragma unroll
    for (int a = 0; a < 2; ++a)
#pragma unroll
        for (int b = 0; b < 2; ++b)
#pragma unroll
            for (int m = 0; m < 4; ++m)
#pragma unroll
                for (int n = 0; n < 2; ++n) acc[a][b][m][n] = (f32x4){0.f, 0.f, 0.f, 0.f};
    h16x8 At[4][2], B0[2][2], B1[2][2];
    unsigned cA = cur.a, cB = cur.b;
    const bool use_ct = (EPI == E_RESID) || ((EPI == E_INPROJ || EPI == E_F16 || EPI == E_SWIGLU) && g.fold);
    const bool use_st = use_ct || EPI == E_QUP || EPI == E_KUP || EPI == E_VTUP;
    const float* const stsrc = (EPI == E_QUP || EPI == E_KUP || EPI == E_VTUP) ? (const float*)(ws + WS_SSQ) : g.st_in;
    const float* const ctA = (EPI == E_RESID) ? g.res : g.cs; const float* const ctB = (EPI == E_RESID) ? g.bias : g.cs + 2 * NCS;
#define STATS_DMA(r0, sel) __builtin_amdgcn_global_load_lds((const unsigned*)(stsrc + (size_t)((r0) + wid * 32 + (lane >> 1)) * 8 + (lane & 1) * 4), (LAS unsigned*)(lds + LDS_STATS + (sel) * 8192 + wid * 1024), 16, 0, 0)
#define COLS_DMA(c0, sel) __builtin_amdgcn_global_load_lds((const unsigned*)((wid == 0 ? ctA : ctB) + (c0) + lane * 4), (LAS unsigned*)(lds + LDS_COLS + (sel) * 2048 + wid * 1024), 16, 0, 0)
    if (use_st) STATS_DMA((EPI == E_VTUP) ? cur.col0 : cur.row0, 0);
    if (use_ct && wid < 2) COLS_DMA(cur.col0, 0);
    STAGE(SB(0, 0), gB, cB, voffB); STAGE(SB(0, 1), gB, cB + hstepB, voffB); STAGE(SA(0, 0), gA, cA, voffA); STAGE(SA(0, 1), gA, cA + hstepA, voffA);
    if (wr == 1) BAR;
    WAIT_V(2); BAR;
    STAGE(SB(1, 0), gB, cB + kstep, voffB); STAGE(SA(1, 0), gA, cA + kstep, voffA); STAGE(SB(1, 1), gB, cB + hstepB + kstep, voffB);
    WAIT_V(6); BAR;
    for (;;) {
        const int nrow0 = (ui + 1 < 32) ? UT(ui + 1, 0) : -1;
        const bool has_next = nrow0 >= 0;
        const unsigned nA = has_next ? (unsigned)UT(ui + 1, 3) : cA, nB = has_next ? (unsigned)UT(ui + 1, 4) : cB;
        for (int t = 0; t < nt; t += 2) {
            const bool last = (t == nt - 2);
            const unsigned a1 = cA + (unsigned)(t + 1) * kstep;
            const unsigned a2 = last ? nA : cA + (unsigned)(t + 2) * kstep, b2 = last ? nB : cB + (unsigned)(t + 2) * kstep;
            const unsigned a3 = a2 + kstep, b3 = b2 + kstep;
            LDB(B0, 0, 0); LDB(B1, 0, 1); SCHED; LDA(At, 0, 0); STAGE(SA(1, 1), gA, a1 + hstepA, voffA);
            WAIT_V(8); WAIT_L(0); BAR; MMA(0, 0, At, B0); MMA(0, 1, At, B1); BAR; SCHED;
            LDA(At, 0, 1); STAGE(SB(0, 0), gB, b2, voffB); STAGE(SB(0, 1), gB, b2 + hstepB, voffB); STAGE(SA(0, 0), gA, a2, voffA);
            WAIT_V(8); WAIT_L(0); BAR; MMA(1, 0, At, B0); MMA(1, 1, At, B1); BAR; SCHED;
            LDB(B0, 1, 0); LDB(B1, 1, 1); SCHED; LDA(At, 1, 0); STAGE(SA(0, 1), gA, a2 + hstepA, voffA);
            WAIT_V(8); WAIT_L(0); BAR; MMA(0, 0, At, B0); MMA(0, 1, At, B1); BAR; SCHED;
            LDA(At, 1, 1); STAGE(SB(1, 0), gB, b3, voffB); STAGE(SB(1, 1), gB, b3 + hstepB, voffB); STAGE(SA(1, 0), gA, a3, voffA);
            WAIT_V(8); WAIT_L(0); BAR; MMA(1, 0, At, B0); MMA(1, 1, At, B1); BAR; SCHED;
        }
        if (wr == 0) BAR;
        epilogue<EPI>(g, cur, acc, wr, wc, fr, fq, lds, ws, (const LAS float*)(lds + LDS_STATS + (ui & 1) * 8192), (const LAS float*)(lds + LDS_COLS + (ui & 1) * 2048));
        if (has_next) { if (use_st) STATS_DMA((EPI == E_VTUP) ? UT(ui + 1, 1) : nrow0, (ui + 1) & 1); if (use_ct && wid < 2) COLS_DMA(UT(ui + 1, 1), (ui + 1) & 1); }
        if (!has_next) break;
#pragma unroll
        for (int a = 0; a < 2; ++a)
#pragma unroll
            for (int b = 0; b < 2; ++b)
#pragma unroll
                for (int m = 0; m < 4; ++m)
#pragma unroll
                    for (int n = 0; n < 2; ++n) acc[a][b][m][n] = (f32x4){0.f, 0.f, 0.f, 0.f};
        ++ui;
        cur.row0 = nrow0; cur.col0 = UT(ui, 1); cur.pn = UT(ui, 2); cur.a = nA; cur.b = nB; cA = nA; cB = nB;
        if (wr == 1) BAR;
    }
    WAIT_V(0);
    BAR;
#undef STATS_DMA
#undef COLS_DMA
#undef UT
#undef SA
#undef SB
#undef STAGE
#undef LDA
#undef LDB
#undef MMA
#undef WAIT_V
#undef WAIT_L
#undef BAR
#undef SCHED
}

__device__ const double INV_FREQ[16] = {1.0, 0.5623413251903491, 0.31622776601683794, 0.1778279410038923, 0.1, 0.05623413251903491, 0.03162277660168379,
    0.01778279410038923, 0.01, 0.005623413251903491, 0.0031622776601683794, 0.0017782794100389228, 0.001, 0.0005623413251903491, 0.00031622776601683794, 0.00017782794100389227};

__device__ __forceinline__ void transpose_item(const float* W, int K, int N, h16* WT, int drow, bool rperm, const float* kscale, const float* kbias, float* part, LAS float* scr, int k0, int n0, int lane) {
    { float wv[32];
#pragma unroll
      for (int i = 0; i < 32; ++i) wv[i] = W[(size_t)(k0 + 2 * i + (lane >> 5)) * N + n0 + (lane & 31)];
#pragma unroll
      for (int i = 0; i < 32; ++i) scr[(2 * i + (lane >> 5)) * 33 + (lane & 31)] = wv[i]; }
    asm volatile("s_waitcnt lgkmcnt(0)" ::: "memory");
    const int c = lane & 7;
    float sc[8];
#pragma unroll
    for (int e = 0; e < 8; ++e) sc[e] = kscale ? kscale[k0 + 8 * c + e] : 1.f;
#pragma unroll
    for (int j = 0; j < 4; ++j) { const int n = (lane >> 3) + 8 * j; const LAS float* s = scr + (8 * c) * 33 + n;
        h16x8 o;
#pragma unroll
        for (int e = 0; e < 8; ++e) o[e] = (h16)(s[e * 33] * sc[e]);
        *(h16x8*)(WT + (size_t)(drow + (rperm ? perm32(n) : n)) * K + k0 + 8 * c) = o; }
    if (part) {
        const float myks = kscale[k0 + lane], mykb = kbias[k0 + lane];
        float a = 0.f, b = 0.f; const int n = lane & 31, kh = (lane >> 5) * 32;
#pragma unroll
        for (int kk = 0; kk < 32; ++kk) { const float w = scr[(kh + kk) * 33 + n];
            a += w * __shfl(myks, kh + kk); b += w * __shfl(mykb, kh + kk); }
        a += __shfl_xor(a, 32); b += __shfl_xor(b, 32);
        if (lane < 32) *(f32x2*)(part + ((size_t)(drow + (rperm ? perm32(lane) : lane)) * 16 + (k0 >> 6)) * 2) = (f32x2){a, b};
    }
    asm volatile("s_waitcnt lgkmcnt(0)" ::: "memory");
}

__device__ __forceinline__ void prologue(LAS unsigned char* lds, KP P) {
    const int tid = tid_here(), lane = tid & 63, wave = tid >> 6, bid = bid_here();
    const int G = gridDim.x, gw = bid * 8 + wave, NGW = G * 8;
    const long gt = (long)bid * 512 + tid, NGT = (long)G * 512;
    LAS float* scr = (LAS float*)(lds + wave * 16384);
    constexpr int NJ = 9;
    const int jK[NJ] = {1024, 256, 256, 1024, 1024, 1024, 1024, 1024, 2816};
    const int jN[NJ] = {1568, 768, 1024, 1024, 1024, 2048, 1024, 5632, 1024};
    const int jin[NJ] = {3, 6, 8, 13, 16, 17, 18, 21, 22};
    const size_t jdst[NJ] = {WO_WIN, WO_WUQ, WO_WUK, WO_WO, WO_XWQ, WO_XWKV, WO_XWO, WO_FWIN, WO_FWD};
    int items_per_layer = 0;
#pragma unroll
    for (int j = 0; j < NJ; ++j) items_per_layer += (jK[j] / 64) * (jN[j] / 32);
    for (int it = gw; it < 2 * items_per_layer; it += NGW) {
        const int l = it / items_per_layer; int r = it % items_per_layer; int j = 0;
#pragma unroll
        for (int jj = 0; jj < NJ - 1; ++jj) { const int cnt = (jK[jj] / 64) * (jN[jj] / 32); if (j == jj && r >= cnt) { r -= cnt; j = jj + 1; } }
        int K = 0, N = 0, ini = 0; size_t dsto = 0;
#pragma unroll
        for (int jj = 0; jj < NJ; ++jj) if (j == jj) { K = jK[jj]; N = jN[jj]; ini = jin[jj]; dsto = jdst[jj]; }
        const int nblk = N / 32, kb = r / nblk, nb = r % nblk, n0 = nb * 32;
        int drow = n0; const float* ks = nullptr; const float* kbs = nullptr; float* part = nullptr; bool rperm = false;
        float* partl = (float*)(P->ws + WS_PART) + (size_t)l * NCS * 32;
        if (j == 0) { drow = n0 < 512 ? n0 : (n0 < 544 ? 1536 + (n0 - 512) : n0 - 32); rperm = (n0 == 512); if (l > 0) { ks = P->in[23] + (l - 1) * DM; kbs = P->in[24] + (l - 1) * DM; part = partl; } }
        else if (j == 4) { ks = P->in[14] + l * DM; kbs = P->in[15] + l * DM; part = partl + (size_t)1792 * 32; }
        else if (j == 1) { ks = P->in[5] + l * 256; rperm = (nb % 3 == 2); }
        else if (j == 2) { const int h = nb >> 2, part = nb & 3; drow = part < 2 ? h * 64 + 32 * part : 512 + h * 64 + 32 * (part - 2); ks = P->in[7] + l * 256; }
        else if (j == 7) { const int jj = n0 < FFH ? n0 : n0 - FFH; drow = (jj >> 7) * 256 + (jj & 127) + (n0 < FFH ? 0 : 128); ks = P->in[19] + l * DM; kbs = P->in[20] + l * DM; part = partl + (size_t)(1792 + 1024) * 32; }
        transpose_item(P->in[ini] + (size_t)l * K * N, K, N, (h16*)(P->ws + WS_W + (size_t)l * 32 * MiB) + dsto, drow, rperm, ks, kbs, part, scr, kb * 64, n0, lane);
    }
    for (long i = gt; i < 2L * 224 * 1024 / 8; i += NGT) { const int l = (int)(i / (224 * 1024 / 8)); const long r = i % (224 * 1024 / 8);
        unsigned zz = 0; asm volatile("" : "+v"(zz));
        *(u32x4*)((h16*)(P->ws + WS_W + (size_t)l * 32 * MiB) + WO_WIN + (size_t)1568 * 1024 + r * 8) = (u32x4){zz, zz, zz, zz}; }
    for (long i = gt; i < 2 * 1792; i += NGT) { const int l = (int)(i / 1792), r = (int)(i % 1792);
        const int src = r < 512 ? r : (r < 1536 ? r + 32 : (r < 1568 ? 512 + (r - 1536) : -1));
        ((float*)(P->ws + WS_BIAS))[i] = src >= 0 ? P->in[4][l * 1568 + src] : 0.f; }
    for (long i = gt; i < (long)TT * 16; i += NGT) { const int tok = (int)(i >> 4), f = (int)(i & 15);
        const double ang = (double)P->pos[tok] * INV_FREQ[f];
        const double kq = __builtin_rint(ang * 0.6366197723675814); const double r = (ang - kq * 1.5707963267948966) - kq * 6.123233995736766e-17;
        const double r2 = r * r;
        const double sn = r * (1.0 + r2 * (-1.0 / 6 + r2 * (1.0 / 120 + r2 * (-1.0 / 5040 + r2 * (1.0 / 362880 + r2 * (-1.0 / 39916800))))));
        const double cs = 1.0 + r2 * (-0.5 + r2 * (1.0 / 24 + r2 * (-1.0 / 720 + r2 * (1.0 / 40320 + r2 * (-1.0 / 3628800 + r2 * (1.0 / 479001600))))));
        const int q = (int)((long long)kq & 3);
        const double c = q == 0 ? cs : (q == 1 ? -sn : (q == 2 ? -cs : sn));
        const double s = q == 0 ? sn : (q == 1 ? cs : (q == 2 ? -sn : -cs));
        ((float*)(P->ws + WS_COS))[i] = (float)c; ((float*)(P->ws + WS_SIN))[i] = (float)s; }
    {
        const long n8x = (long)TT * DM / 8, n8m = (long)MEMT * DM / 8;
        for (int pass = 0; pass < 2; ++pass) {
            const f32x4* src = (const f32x4*)(pass == 0 ? P->in[0] : P->in[1]); h16x8* dst = (h16x8*)(P->ws + (pass == 0 ? WS_XH : WS_MEMH)); const long n8 = pass == 0 ? n8x : n8m;
            for (long i = gt; i < n8; i += 4 * NGT) {
                f32x4 a[4], b[4];
#pragma unroll
                for (int q = 0; q < 4; ++q) { const long ii = i + q * NGT; if (ii < n8) { a[q] = src[2 * ii]; b[q] = src[2 * ii + 1]; } }
#pragma unroll
                for (int q = 0; q < 4; ++q) { const long ii = i + q * NGT; if (ii < n8) { h16x8 o; o[0] = (h16)a[q][0]; o[1] = (h16)a[q][1]; o[2] = (h16)a[q][2]; o[3] = (h16)a[q][3]; o[4] = (h16)b[q][0]; o[5] = (h16)b[q][1]; o[6] = (h16)b[q][2]; o[7] = (h16)b[q][3]; dst[ii] = o; } }
            }
        }
    }
}

__device__ __forceinline__ void csbw_finalize(KP P) {
    const long gt = (long)bid_here() * 512 + tid_here(), NGT = (long)gridDim.x * 512;
    const float* part = (const float*)(P->ws + WS_PART); float* cs = (float*)(P->ws + WS_CSBW);
    for (long i = gt; i < 2L * NCS; i += NGT) { const int c = (int)(i % NCS); float a = 0.f, b = 0.f;
        if (!(c >= 1568 && c < 1792) && !(i < 1792)) {
            const f32x2* p = (const f32x2*)part + i * 16;
#pragma unroll
            for (int k = 0; k < 16; ++k) { const f32x2 v = p[k]; a += v[0]; b += v[1]; } }
        cs[i] = a; cs[2 * NCS + i] = b; }
}
__device__ __forceinline__ void ln_final(KP P, const float* gam, const float* bet) {
    const int tid = tid_here(), lane = tid & 63, wave = tid >> 6;
    const int gw = bid_here() * 8 + wave, NGW = gridDim.x * 8;
    f32x4 gv[4], bv[4];
#pragma unroll
    for (int j = 0; j < 2; ++j) { gv[2 * j] = ((const f32x4*)gam)[128 * j + 2 * lane]; gv[2 * j + 1] = ((const f32x4*)gam)[128 * j + 2 * lane + 1];
                                  bv[2 * j] = ((const f32x4*)bet)[128 * j + 2 * lane]; bv[2 * j + 1] = ((const f32x4*)bet)[128 * j + 2 * lane + 1]; }
    for (int row0 = gw * 2; row0 < TT; row0 += NGW * 2) {
        h16x8 z[2][2];
#pragma unroll
        for (int r = 0; r < 2; ++r)
#pragma unroll
            for (int j = 0; j < 2; ++j) z[r][j] = ((const h16x8*)((const h16*)(P->ws + WS_XH) + (size_t)(row0 + r) * DM))[64 * j + lane];
#pragma unroll
        for (int r = 0; r < 2; ++r) {
            f32x4 v[4]; float s = 0.f;
#pragma unroll
            for (int j = 0; j < 2; ++j) { v[2 * j] = (f32x4){(float)z[r][j][0], (float)z[r][j][1], (float)z[r][j][2], (float)z[r][j][3]}; v[2 * j + 1] = (f32x4){(float)z[r][j][4], (float)z[r][j][5], (float)z[r][j][6], (float)z[r][j][7]}; }
#pragma unroll
            for (int j = 0; j < 4; ++j) s += (v[j][0] + v[j][1]) + (v[j][2] + v[j][3]);
            const float mean = wave_sum(s) * (1.f / DM); float s2 = 0.f;
#pragma unroll
            for (int j = 0; j < 4; ++j) { v[j] = v[j] - mean; s2 += (v[j][0] * v[j][0] + v[j][1] * v[j][1]) + (v[j][2] * v[j][2] + v[j][3] * v[j][3]); }
            const float rstd = 1.f / sqrtf(wave_sum(s2) * (1.f / DM) + 1e-5f);
            f32x4* xr = (f32x4*)(P->out + (size_t)(row0 + r) * DM);
#pragma unroll
            for (int j = 0; j < 2; ++j) { xr[128 * j + 2 * lane] = v[2 * j] * rstd * gv[2 * j] + bv[2 * j]; xr[128 * j + 2 * lane + 1] = v[2 * j + 1] * rstd * gv[2 * j + 1] + bv[2 * j + 1]; }
        }
    }
}

__device__ __forceinline__ void conv_phase(LAS unsigned char* lds, KP P, int l) {
    const int tid = tid_here(), lane = tid & 63, wave = tid >> 6;
    const h16* PROJ = (const h16*)(P->ws + WS_PROJ); h16* YC = (h16*)(P->ws + WS_YCAT);
    LAS unsigned* hp = (LAS unsigned*)lds;
    LAS float* cb = (LAS float*)(lds + 65536);
    h16x2 wE[16], wO[16];
    { float w[31];
#pragma unroll
      for (int j = 0; j < 31; ++j) w[j] = P->in[9][(size_t)l * 31 * 512 + j * 512 + tid];
#pragma unroll
      for (int i = 0; i < 15; ++i) { wE[i] = (h16x2){(h16)w[2 * i], (h16)w[2 * i + 1]}; wO[i + 1] = (h16x2){(h16)w[2 * i + 1], (h16)w[2 * i + 2]}; }
      wE[15] = (h16x2){(h16)w[30], (h16)0.f}; wO[0] = (h16x2){(h16)0.f, (h16)w[0]}; }
    const float bias = P->in[10][l * 512 + tid];
    f32x4 ng[2], nbv[2];
#pragma unroll
    for (int j = 0; j < 2; ++j) { ng[j] = *(const f32x4*)(P->in[11] + l * 512 + lane * 8 + 4 * j); nbv[j] = *(const f32x4*)(P->in[12] + l * 512 + lane * 8 + 4 * j); }
    h16x8 ra0[4], rg0[4], ra1[4], rg1[4];
#define CONV_LOAD(uu) do { const int b_ = (uu) >> 6, t0_ = ((uu) & 63) * 32; \
        _Pragma("unroll") for (int k_ = 0; k_ < 4; ++k_) { const int idx_ = tid + 512 * k_; const int pr_ = idx_ >> 6, c8_ = idx_ & 63, tok_ = t0_ - 30 + 2 * pr_; \
            if (idx_ < 31 * 64 && tok_ >= 0) { const h16* src_ = PROJ + (size_t)(b_ * SEQ + tok_) * PROJW + 512 + c8_ * 8; \
                ra0[k_] = *(const h16x8*)src_; rg0[k_] = *(const h16x8*)(src_ + 512); ra1[k_] = *(const h16x8*)(src_ + PROJW); rg1[k_] = *(const h16x8*)(src_ + PROJW + 512); } } } while (0)
#define CONV_GLU(uu) do { const int t0_ = ((uu) & 63) * 32; \
        _Pragma("unroll") for (int k_ = 0; k_ < 4; ++k_) { const int idx_ = tid + 512 * k_; const int pr_ = idx_ >> 6, c8_ = idx_ & 63, tok_ = t0_ - 30 + 2 * pr_; \
            if (idx_ < 31 * 64) { u32x4 d0_ = {0u, 0u, 0u, 0u}, d1_ = {0u, 0u, 0u, 0u}; \
                if (tok_ >= 0) { \
                    _Pragma("unroll") for (int e = 0; e < 8; ++e) { \
                        const float h0_ = (float)ra0[k_][e] * __builtin_amdgcn_rcpf(1.f + fast_exp2((float)rg0[k_][e] * -1.4426950408889634f)); \
                        const float h1_ = (float)ra1[k_][e] * __builtin_amdgcn_rcpf(1.f + fast_exp2((float)rg1[k_][e] * -1.4426950408889634f)); \
                        const h16x2 pk_ = {(h16)h0_, (h16)h1_}; const unsigned w_ = __builtin_bit_cast(unsigned, pk_); \
                        if (e < 4) d0_[e] = w_; else d1_[e - 4] = w_; } } \
                *(LAS u32x4*)(hp + pr_ * 512 + c8_ * 8) = d0_; *(LAS u32x4*)(hp + pr_ * 512 + c8_ * 8 + 4) = d1_; } } } while (0)
    const int u_first = bid_here();
    if (u_first < TT / 32) { CONV_LOAD(u_first); CONV_GLU(u_first); }
    LDS_BARRIER();
    for (int u = u_first; u < TT / 32; u += gridDim.x) {
        const int b = u >> 6, t0 = (u & 63) * 32;
        const int un = u + gridDim.x; const bool has_next = un < TT / 32;
        if (has_next) CONV_LOAD(un);
        for (int m = 0; m < 16; ++m) {
            float a0 = bias, a1 = bias;
#pragma unroll
            for (int i = 0; i < 16; ++i) { const h16x2 p = __builtin_bit_cast(h16x2, hp[(m + i) * 512 + tid]);
                a0 = __builtin_amdgcn_fdot2(p, wE[i], a0, false); a1 = __builtin_amdgcn_fdot2(p, wO[i], a1, false); }
            cb[(2 * m) * 512 + tid] = a0; cb[(2 * m + 1) * 512 + tid] = a1;
        }
        LDS_BARRIER();
        if (has_next) CONV_GLU(un);
#pragma unroll
        for (int k = 0; k < 4; ++k) {
            const int lt = wave * 4 + k;
            f32x4 v0 = *(const LAS f32x4*)(cb + lt * 512 + lane * 8), v1 = *(const LAS f32x4*)(cb + lt * 512 + lane * 8 + 4);
            const float mean = wave_sum((v0[0] + v0[1]) + (v0[2] + v0[3]) + (v1[0] + v1[1]) + (v1[2] + v1[3])) * (1.f / 512.f);
            v0 = v0 - mean; v1 = v1 - mean;
            const float var = wave_sum((v0[0] * v0[0] + v0[1] * v0[1]) + (v0[2] * v0[2] + v0[3] * v0[3]) + (v1[0] * v1[0] + v1[1] * v1[1]) + (v1[2] * v1[2] + v1[3] * v1[3])) * (1.f / 512.f);
            const float rstd = 1.f / sqrtf(var + 1e-5f);
            v0 = v0 * rstd * ng[0] + nbv[0]; v1 = v1 * rstd * ng[1] + nbv[1];
            h16x8 o;
#pragma unroll
            for (int e = 0; e < 4; ++e) { o[e] = (h16)(v0[e] * __builtin_amdgcn_rcpf(1.f + fast_exp2(v0[e] * -1.4426950408889634f))); o[4 + e] = (h16)(v1[e] * __builtin_amdgcn_rcpf(1.f + fast_exp2(v1[e] * -1.4426950408889634f))); }
            *(h16x8*)(YC + (size_t)(b * SEQ + t0 + lt) * DM + 512 + lane * 8) = o;
        }
        LDS_BARRIER();
    }
#undef CONV_LOAD
#undef CONV_GLU
}

constexpr int KPITCH = 208, VPITCH = 264;
__device__ __forceinline__ void attn_phase(LAS unsigned char* lds, KP P) {
    const int tid = tid_here(), lane = tid & 63, r32 = lane & 31, hi = lane >> 5; const int wid = __builtin_amdgcn_readfirstlane(tid >> 6);
    const h16* Q = (const h16*)(P->ws + WS_Q); const h16* KN = (const h16*)(P->ws + WS_KN); const h16* KR = (const h16*)(P->ws + WS_KR);
    const h16* VT = (const h16*)(P->ws + WS_VT); h16* YC = (h16*)(P->ws + WS_YCAT);
    LAS unsigned char* Kb = lds; LAS unsigned char* Vb = lds + 2 * 128 * KPITCH; LAS unsigned char* Sg = lds + 2 * 128 * KPITCH + 2 * 64 * VPITCH + wid * (32 * 144);
    for (int u = bid_here(); u < 2048; u += gridDim.x) {
        const int bh = u & 255, qb = 7 - (u >> 8), b = bh >> 3, h = bh & 7;
        const size_t rowbase = (size_t)b * SEQ; const int q0 = qb * 256, NT2 = 2 * qb + 2, my_last = 4 * qb + (wid >> 1);
        h16x8 qf[6];
        { const h16* qp = Q + (rowbase + q0 + wid * 32 + r32) * 768 + h * 96 + 8 * hi;
#pragma unroll
          for (int d0 = 0; d0 < 6; ++d0) qf[d0] = *(const h16x8*)(qp + 16 * d0); }
        u32x4 sk[3], sv[2];
#define LOADT(J) do { const size_t kb_ = rowbase + 128 * (J); \
            _Pragma("unroll") for (int i_ = 0; i_ < 3; ++i_) { const int c_ = tid + 512 * i_, kr_ = c_ / 12, kc_ = c_ % 12; \
                sk[i_] = kc_ < 8 ? *(const u32x4*)(KN + (kb_ + kr_) * 512 + h * 64 + kc_ * 8) : *(const u32x4*)(KR + (kb_ + kr_) * 32 + (kc_ - 8) * 8); } \
            _Pragma("unroll") for (int i_ = 0; i_ < 2; ++i_) { const int c_ = tid + 512 * i_; \
                sv[i_] = *(const u32x4*)(VT + (size_t)(h * 64 + (c_ >> 4)) * TT + kb_ + (c_ & 15) * 8); } } while (0)
#define STORET(buf) do { \
            _Pragma("unroll") for (int i_ = 0; i_ < 3; ++i_) { const int c_ = tid + 512 * i_, kr_ = c_ / 12, kc_ = c_ % 12; \
                *(LAS u32x4*)(Kb + (buf) * 128 * KPITCH + kr_ * KPITCH + kc_ * 16) = sk[i_]; } \
            _Pragma("unroll") for (int i_ = 0; i_ < 2; ++i_) { const int c_ = tid + 512 * i_; LAS unsigned char* vd_ = Vb + (buf) * 64 * VPITCH + (c_ >> 4) * VPITCH + (c_ & 15) * 16; \
                *(LAS unsigned long long*)vd_ = ((unsigned long long)sv[i_][1] << 32) | sv[i_][0]; \
                *(LAS unsigned long long*)(vd_ + 8) = ((unsigned long long)sv[i_][3] << 32) | sv[i_][2]; } } while (0)
        LOADT(0); STORET(0);
        __syncthreads();
        f32x16 o0, o1; float m_run = -INFINITY, lsum = 0.f;
#pragma unroll
        for (int r = 0; r < 16; ++r) { o0[r] = 0.f; o1[r] = 0.f; }
        auto compute = [&](const LAS unsigned char* kbase, const LAS unsigned char* vbase) {
                f32x16 p0, p1;
#pragma unroll
                for (int r = 0; r < 16; ++r) { p0[r] = 0.f; p1[r] = 0.f; }
                const LAS unsigned char* kp = kbase + r32 * KPITCH + hi * 16;
                const LAS unsigned char* vp = vbase + r32 * VPITCH + hi * 8;
                h16x8 kf[12];
#pragma unroll
                for (int d0 = 0; d0 < 6; ++d0) { kf[2 * d0] = *(const LAS h16x8*)(kp + d0 * 32); kf[2 * d0 + 1] = *(const LAS h16x8*)(kp + 32 * KPITCH + d0 * 32); }
                __builtin_amdgcn_sched_barrier(0);
#pragma unroll
                for (int d0 = 0; d0 < 6; ++d0) {
                    p0 = __builtin_amdgcn_mfma_f32_32x32x16_f16(kf[2 * d0], qf[d0], p0, 0, 0, 0);
                    p1 = __builtin_amdgcn_mfma_f32_32x32x16_f16(kf[2 * d0 + 1], qf[d0], p1, 0, 0, 0);
                }
                h16x4 vf[4][4];
#pragma unroll
                for (int t = 0; t < 4; ++t) { const int kbyte = (32 * (t >> 1) + 16 * (t & 1)) * 2;
                    vf[t][0] = *(const LAS h16x4*)(vp + kbyte); vf[t][1] = *(const LAS h16x4*)(vp + kbyte + 16);
                    vf[t][2] = *(const LAS h16x4*)(vp + 32 * VPITCH + kbyte); vf[t][3] = *(const LAS h16x4*)(vp + 32 * VPITCH + kbyte + 16); }
                __builtin_amdgcn_sched_barrier(0);
                float mx = fmaxf(p0[0], p1[0]);
#pragma unroll
                for (int r = 1; r < 16; ++r) mx = fmaxf(mx, fmaxf(p0[r], p1[r]));
                mx = fmaxf(mx, __shfl_xor(mx, 32));
                const float m_new = fmaxf(m_run, mx), alpha = fast_exp2(m_run - m_new); m_run = m_new;
                float ps = 0.f;
#pragma unroll
                for (int r = 0; r < 16; ++r) { p0[r] = fast_exp2(p0[r] - m_new); p1[r] = fast_exp2(p1[r] - m_new); ps += p0[r] + p1[r]; }
                lsum = lsum * alpha + ps;
#pragma unroll
                for (int r = 0; r < 16; ++r) { o0[r] *= alpha; o1[r] *= alpha; }
                h16x8 pb[4];
#pragma unroll
                for (int e = 0; e < 8; ++e) { pb[0][e] = (h16)p0[e]; pb[1][e] = (h16)p0[8 + e]; pb[2][e] = (h16)p1[e]; pb[3][e] = (h16)p1[8 + e]; }
#pragma unroll
                for (int t = 0; t < 4; ++t) {
                    const h16x8 va = {vf[t][0][0], vf[t][0][1], vf[t][0][2], vf[t][0][3], vf[t][1][0], vf[t][1][1], vf[t][1][2], vf[t][1][3]};
                    const h16x8 vc2 = {vf[t][2][0], vf[t][2][1], vf[t][2][2], vf[t][2][3], vf[t][3][0], vf[t][3][1], vf[t][3][2], vf[t][3][3]};
                    o0 = __builtin_amdgcn_mfma_f32_32x32x16_f16(va, pb[t], o0, 0, 0, 0);
                    o1 = __builtin_amdgcn_mfma_f32_32x32x16_f16(vc2, pb[t], o1, 0, 0, 0);
                }
        };
        for (int J = 0; J < NT2; ++J) {
            const int buf = J & 1;
            if (J + 1 < NT2) LOADT(J + 1);
            if (2 * J <= my_last) compute(Kb + buf * 128 * KPITCH, Vb + buf * 64 * VPITCH);
            if (2 * J + 1 <= my_last) compute(Kb + buf * 128 * KPITCH + 64 * KPITCH, Vb + buf * 64 * VPITCH + 128);
            if (J + 1 < NT2) STORET(buf ^ 1);
            __syncthreads();
        }
#undef LOADT
#undef STORET
        lsum += __shfl_xor(lsum, 32);
        const float inv = 1.f / lsum;
        LAS h16* sg = (LAS h16*)Sg;
#pragma unroll
        for (int r = 0; r < 16; ++r) { const int d = (r & 3) + 8 * (r >> 2) + 4 * hi; sg[r32 * 72 + d] = (h16)(o0[r] * inv); sg[r32 * 72 + 32 + d] = (h16)(o1[r] * inv); }
        asm volatile("s_waitcnt lgkmcnt(0)" ::: "memory");
#pragma unroll
        for (int i = 0; i < 4; ++i) { const int id = i * 64 + lane, row = id >> 3, c = id & 7;
            const u32x4 v = *(const LAS u32x4*)(Sg + row * 144 + c * 16);
            *(u32x4*)(YC + (rowbase + q0 + wid * 32 + row) * DM + h * 64 + c * 8) = v; }
        asm volatile("s_waitcnt lgkmcnt(0)" ::: "memory");
    }
}


#define XB_TMO      128
#define XB_XCNT(j)  (256  + 64 * (j))
#define XB_XSUB(j)  (1280 + 64 * (j))
#define XB_XGEN(j)  (2304 + 64 * (j))
#define XB_TOP      3328
#define XB_TOPGEN   3392
#define XCD_BAR_WORDS 3456
#define XB_SPIN_CAP (1u << 18)
__device__ __forceinline__ unsigned xb_ld(unsigned* p)              { return __hip_atomic_load(p, __ATOMIC_RELAXED, __HIP_MEMORY_SCOPE_AGENT); }
__device__ __forceinline__ unsigned xb_add(unsigned* p, unsigned v) { return __hip_atomic_fetch_add(p, v, __ATOMIC_RELAXED, __HIP_MEMORY_SCOPE_AGENT); }
__device__ __forceinline__ unsigned xb_xcc_id() { return (unsigned)__builtin_amdgcn_s_getreg((3 << 11) | 20) & 0xFu; }
#define XB_SPIN(cond, bar) do { unsigned _sp = 0; while (cond) { __builtin_amdgcn_s_sleep(1); \
    if ((++_sp & 255u) == 0u) { if (xb_ld(&(bar)[XB_TMO])) break; if (_sp > XB_SPIN_CAP) { atomicAdd(&(bar)[XB_TMO], 1u); break; } } } } while (0)
struct XcdBarrier { unsigned* bar; unsigned x; volatile LAS unsigned* st; };
__device__ __forceinline__ XcdBarrier xcd_barrier_post(unsigned* bar, volatile LAS unsigned* st) {
    XcdBarrier b; b.bar = bar; b.x = xb_xcc_id(); b.st = st;
    if (threadIdx.x == 0) (void)xb_add(&bar[XB_XCNT(b.x)], 1u);
    return b;
}
__device__ __forceinline__ void xcd_barrier_complete(unsigned* bar, unsigned x, unsigned& nloc, unsigned& nx) {
    const unsigned G = gridDim.x * gridDim.y * gridDim.z;
    unsigned sum, cnt, mine, sp = 0u;
    for (;;) {
        sum = 0u; cnt = 0u; mine = 0u;
#pragma unroll
        for (unsigned j = 0; j < 16; ++j) { const unsigned c = xb_ld(&bar[XB_XCNT(j)]); sum += c; cnt += (c > 0u) ? 1u : 0u; mine = (j == x) ? c : mine; }
        if (sum == G) break;
        __builtin_amdgcn_s_sleep(1);
        if ((++sp & 255u) == 0u) { if (xb_ld(&bar[XB_TMO])) break; if (sp > XB_SPIN_CAP) { atomicAdd(&bar[XB_TMO], 1u); break; } }
    }
    nloc = mine > 0u ? mine : 1u; nx = cnt > 0u ? cnt : 1u;
}
__device__ __forceinline__ void xcd_barrier(const XcdBarrier& b) {
    asm volatile("s_waitcnt vmcnt(0)" ::: "memory");
    __syncthreads();
    if (threadIdx.x == 0) {
        unsigned* bar = (unsigned*)(kparams()->ws + WS_BAR); asm volatile("" : "+v"(bar));
        __builtin_amdgcn_s_waitcnt(0);
        unsigned nloc = b.st[0], nx = b.st[1];
        if (nloc == 0u) { xcd_barrier_complete(bar, b.x, nloc, nx); b.st[0] = nloc; b.st[1] = nx; }
        const unsigned old = xb_add(&bar[XB_XSUB(b.x)], 1u);
        const unsigned gen = old / nloc;
        if (old + 1u == (gen + 1u) * nloc) {
            __builtin_amdgcn_fence(__ATOMIC_RELEASE, "agent");
            asm volatile("s_waitcnt vmcnt(0)" ::: "memory");
            const unsigned og = xb_add(&bar[XB_TOP], 1u);
            const unsigned tg = og / nx;
            if (og + 1u == (tg + 1u) * nx) xb_add(&bar[XB_TOPGEN], 1u);
            else XB_SPIN(xb_ld(&bar[XB_TOPGEN]) == tg, bar);
            __builtin_amdgcn_fence(__ATOMIC_ACQUIRE, "agent");
            xb_add(&bar[XB_XGEN(b.x)], 1u);
            asm volatile("s_waitcnt vmcnt(0)" ::: "memory");
        } else {
            XB_SPIN(xb_ld(&bar[XB_XGEN(b.x)]) == gen, bar);
            __builtin_amdgcn_fence(__ATOMIC_ACQUIRE, "agent");
            asm volatile("s_waitcnt vmcnt(0)" ::: "memory");
        }
    }
    __syncthreads();
}

struct GT { unsigned long long a, b, o; int lda, ldb, K, nM, nN, nZ1, nZ2, a_s1, a_s2, b_s1, b_s2, epi, ldc, rkind, bias, fold, st_in, st_out, cs, gidx, gl; float scale; int ph; };
__device__ const GT GTAB[] = {
    {WS_MEMH, WS_W + 0ull * 32 * MiB + WO_XWKV * 2, WS_XK, 1024, 1024, 1024, 32, 4, 1, 2, 0, 0, 0, 16777216, E_F16, 2048, 0, -1, 0, 0, 0, 0, 0, 0, 1.f, 1},
    {WS_W + 0ull * 32 * MiB + (WO_XWKV + 1024 * 1024) * 2, WS_MEMH, WS_XVT, 1024, 1024, 1024, 4, 32, 2, 1, 16777216, 0, 0, 0, E_F16, MEMT, 0, -1, 0, 0, 0, 0, 0, 0, 1.f, 1},
    {WS_XH, WS_W + 0ull * 32 * MiB + WO_WIN * 2, WS_PROJ, 1024, 1024, 1024, 256, 7, 1, 1, 0, 0, 0, 0, E_INPROJ, 0, 0, (int)WS_BIAS, 0, 0, 0, 0, 0, 0, 1.f, 1},
    {WS_PROJ, WS_W + 0ull * 32 * MiB + WO_WUQ * 2, WS_Q, PROJW, 256, 256, 256, 3, 1, 1, 0, 0, 0, 0, E_QUP, 0, 0, -1, 0, 0, 0, 0, 0, 0, 1.f, 3},
    {WS_PROJ + 512, WS_W + 0ull * 32 * MiB + WO_WUK * 2, WS_KN, PROJW, 256, 256, 256, 2, 1, 1, 0, 0, 0, 0, E_KUP, 0, 0, -1, 0, 0, 0, 0, 0, 0, 1.f, 3},
    {WS_W + 0ull * 32 * MiB + WO_WUV * 2, WS_PROJ + 512, WS_VT, 256, PROJW, 256, 2, 256, 1, 1, 0, 0, 0, 0, E_VTUP, 0, 0, -1, 0, 0, 0, 0, 0, 0, 1.f, 3},
    {WS_YCAT, WS_W + 0ull * 32 * MiB + WO_WO * 2, 0, 1024, 1024, 1024, 256, 4, 1, 1, 0, 0, 0, 0, E_RESID0, 0, 1, -1, 0, 0, 0, 0, 0, 0, 1.f, 5},
    {WS_XH, WS_W + 0ull * 32 * MiB + WO_XWQ * 2, WS_XQ, 1024, 1024, 1024, 256, 4, 1, 1, 0, 0, 0, 0, E_F16, 1024, 0, -1, 1, 0, 0, 0 * NCS + 1792, 0, 0, XQSCALE, 7},
    {WS_XQ, WS_XK + 0 * 2048, WS_P, 1024, 2048, 256, 8, 1, 32, 4, SEQ * 1024, 256, 256 * 2048, 256, E_SOFTMAX, 0, 0, -1, 0, 0, 0, 0, 0, 0, 1.f, 8},
    {WS_P, WS_XVT + 0ull * 16 * MiB, WS_XO, 1024, MEMT, 256, 8, 1, 32, 4, SEQ * 1024, 256, 256, 256 * MEMT, E_F16, 1024, 0, -1, 0, 0, 0, 0, 0, 0, 1.f, 9},
    {WS_XO, WS_W + 0ull * 32 * MiB + WO_XWO * 2, 0, 1024, 1024, 1024, 256, 4, 1, 1, 0, 0, 0, 0, E_RESID, 0, 2, -1, 1, 0, 1, 0, 14, 0, 1.f, 10},
    {WS_XH, WS_W + 0ull * 32 * MiB + WO_FWIN * 2, WS_H, 1024, 1024, 1024, 256, 22, 1, 1, 0, 0, 0, 0, E_SWIGLU, 0, 0, -1, 1, 1, 0, 0 * NCS + 2816, 0, 0, 1.f, 12},
    {WS_H, WS_W + 0ull * 32 * MiB + WO_FWD * 2, 0, FFH, FFH, FFH, 256, 4, 1, 1, 0, 0, 0, 0, E_RESID, 0, 2, -1, 1, 1, 0, 0, 19, 0, 1.f, 13},
    {WS_XH, WS_W + 1ull * 32 * MiB + WO_WIN * 2, WS_PROJ, 1024, 1024, 1024, 256, 7, 1, 1, 0, 0, 0, 0, E_INPROJ, 0, 0, (int)WS_BIAS + 1 * 1792 * 4, 1, 0, 0, 1 * NCS, 0, 0, 1.f, 15},
    {WS_PROJ, WS_W + 1ull * 32 * MiB + WO_WUQ * 2, WS_Q, PROJW, 256, 256, 256, 3, 1, 1, 0, 0, 0, 0, E_QUP, 0, 0, -1, 0, 0, 0, 0, 0, 0, 1.f, 16},
    {WS_PROJ + 512, WS_W + 1ull * 32 * MiB + WO_WUK * 2, WS_KN, PROJW, 256, 256, 256, 2, 1, 1, 0, 0, 0, 0, E_KUP, 0, 0, -1, 0, 0, 0, 0, 0, 0, 1.f, 16},
    {WS_W + 1ull * 32 * MiB + WO_WUV * 2, WS_PROJ + 512, WS_VT, 256, PROJW, 256, 2, 256, 1, 1, 0, 0, 0, 0, E_VTUP, 0, 0, -1, 0, 0, 0, 0, 0, 0, 1.f, 16},
    {WS_YCAT, WS_W + 1ull * 32 * MiB + WO_WO * 2, 0, 1024, 1024, 1024, 256, 4, 1, 1, 0, 0, 0, 0, E_RESID, 0, 2, -1, 1, 0, 1, 0, 23, 0, 1.f, 18},
    {WS_XH, WS_W + 1ull * 32 * MiB + WO_XWQ * 2, WS_XQ, 1024, 1024, 1024, 256, 4, 1, 1, 0, 0, 0, 0, E_F16, 1024, 0, -1, 1, 1, 0, 1 * NCS + 1792, 0, 0, XQSCALE, 20},
    {WS_XQ, WS_XK + 1 * 2048, WS_P, 1024, 2048, 256, 8, 1, 32, 4, SEQ * 1024, 256, 256 * 2048, 256, E_SOFTMAX, 0, 0, -1, 0, 0, 0, 0, 0, 0, 1.f, 21},
    {WS_P, WS_XVT + 1ull * 16 * MiB, WS_XO, 1024, MEMT, 256, 8, 1, 32, 4, SEQ * 1024, 256, 256, 256 * MEMT, E_F16, 1024, 0, -1, 0, 0, 0, 0, 0, 0, 1.f, 22},
    {WS_XO, WS_W + 1ull * 32 * MiB + WO_XWO * 2, 0, 1024, 1024, 1024, 256, 4, 1, 1, 0, 0, 0, 0, E_RESID, 0, 2, -1, 1, 1, 0, 0, 14, 1, 1.f, 23},
    {WS_XH, WS_W + 1ull * 32 * MiB + WO_FWIN * 2, WS_H, 1024, 1024, 1024, 256, 22, 1, 1, 0, 0, 0, 0, E_SWIGLU, 0, 0, -1, 1, 0, 0, 1 * NCS + 2816, 0, 0, 1.f, 25},
    {WS_H, WS_W + 1ull * 32 * MiB + WO_FWD * 2, 0, FFH, FFH, FFH, 256, 4, 1, 1, 0, 0, 0, 0, E_RESID, 0, 2, -1, 1, 0, 1, 0, 19, 1, 1.f, 26},
    {0, 0, 0, 0, 0, 0, 0, 0, 0, 0, 0, 0, 0, 0, 0, 0, 0, 0, 0, 0, 0, 0, 0, 0, 0.f, 99},
};
__device__ __forceinline__ void load_gemm(GemmDesc& g, int ti, KP P) {
    const GT& t = GTAB[ti]; unsigned char* ws = P->ws;
    g.A = (const h16*)(ws + t.a); g.B = (const h16*)(ws + t.b); g.lda = t.lda; g.ldb = t.ldb; g.K = t.K; g.nM = t.nM; g.nN = t.nN; g.nZ1 = t.nZ1; g.nZ2 = t.nZ2;
    g.a_s1 = t.a_s1; g.a_s2 = t.a_s2; g.b_s1 = t.b_s1; g.b_s2 = t.b_s2; g.epi = t.epi; g.ldc = t.ldc; g.scale = t.scale; g.fold = t.fold;
    g.out = (void*)(ws + ((t.epi == E_RESID || t.epi == E_RESID0) ? WS_XH : t.o));
    g.st_in = (const float*)(ws + WS_ST) + (size_t)t.st_in * TT * 8; g.st_out = (float*)(ws + WS_ST) + (size_t)t.st_out * TT * 8;
    g.cs = (const float*)(ws + WS_CSBW) + t.cs;
    if (t.rkind == 1) { g.res = P->in[0]; g.bias = nullptr; }
    else if (t.rkind == 2) { g.res = P->in[t.gidx] + t.gl * DM; g.bias = P->in[t.gidx + 1] + t.gl * DM; }
    else { g.res = nullptr; g.bias = (const float*)(ws + (t.bias < 0 ? 0 : t.bias)); }
}

__global__ void __launch_bounds__(512, 2) fwd_megakernel(Params Pval) {
    extern __shared__ __attribute__((aligned(16))) unsigned char lds_raw[];
    LAS unsigned char* lds = (LAS unsigned char*)lds_raw;
    cg::grid_group grid = cg::this_grid();
    volatile LAS unsigned* bst = (volatile LAS unsigned*)(lds + 131072 + 8192 + 1024);
    if (threadIdx.x < 2) bst[threadIdx.x] = 0u;
    XcdBarrier xbar; xbar.bar = nullptr; xbar.x = 0; xbar.st = bst;
    int ti = 0;
    {
        KP P = kparams();
        if (bid_here() == 0) { unsigned* bw = (unsigned*)(P->ws + WS_BAR); for (int i = tid_here(); i < XCD_BAR_WORDS; i += 512) bw[i] = 0u; }
        prologue(lds, P);
        grid.sync();
        xbar = xcd_barrier_post((unsigned*)(P->ws + WS_BAR), bst);
    }
    for (int ph = 1; ph < 28; ++ph) {
        { const int sq = ph < 2 ? -1 : (ph - 2) % 13; if (ph == 2 || sq == 4 || sq == 9 || (sq == 12 && ph != 27)) continue; }
        KP P = kparams();
        {
            const int l = ph < 2 ? 0 : (ph - 2) / 13, s = ph < 2 ? -1 : (ph - 2) % 13;
            if (s == 1) conv_phase(lds, P, l);
            if (s == 2) attn_phase(lds, P);
            if (ph == 1) csbw_finalize(P);
            if (s == 12 && l == 1) ln_final(P, P->in[23] + DM, P->in[24] + DM);
            for (; GTAB[ti].ph == ph; ++ti) {
              {
                GemmDesc g; load_gemm(g, ti, P);
                unsigned char* ws = P->ws;
                __syncthreads();
                switch (g.epi) {
                case E_INPROJ: gemm_run<E_INPROJ>(lds, g, ws); break;
                case E_QUP: gemm_run<E_QUP>(lds, g, ws); break;
                case E_KUP: gemm_run<E_KUP>(lds, g, ws); break;
                case E_VTUP: gemm_run<E_VTUP>(lds, g, ws); break;
                case E_F16: gemm_run<E_F16>(lds, g, ws); break;
                case E_RESID: gemm_run<E_RESID>(lds, g, ws); break;
                case E_RESID0: gemm_run<E_RESID0>(lds, g, ws); break;
                case E_SOFTMAX: gemm_run<E_SOFTMAX>(lds, g, ws); break;
                default: gemm_run<E_SWIGLU>(lds, g, ws); break;
                }
                __syncthreads();
              }
            }
        }
        if (ph != 27) xcd_barrier(xbar);
    }
}

extern "C" void kernel_launch(void* const* d_in, const int* in_sizes, int n_in, void* d_out, int out_size, void* d_ws, size_t ws_size, hipStream_t stream) {
    static int grid_blocks = 0;
    if (!grid_blocks) {
        if (n_in != 25 || ws_size < WS_END) { fprintf(stderr, "kernel_launch: unexpected n_in %d / ws_size %zu\n", n_in, ws_size); grid_blocks = -1; return; }
        int dev = 0, cus = 0, per_cu = 0;
        hipGetDevice(&dev);
        hipDeviceGetAttribute(&cus, hipDeviceAttributeMultiprocessorCount, dev);
        if (hipFuncSetAttribute((const void*)fwd_megakernel, hipFuncAttributeMaxDynamicSharedMemorySize, LDS_BYTES) != hipSuccess) fprintf(stderr, "kernel_launch: hipFuncSetAttribute failed\n");
        hipOccupancyMaxActiveBlocksPerMultiprocessor(&per_cu, (const void*)fwd_megakernel, 512, LDS_BYTES);
        if (per_cu < 1) { fprintf(stderr, "kernel_launch: occupancy query gave %d\n", per_cu); per_cu = 1; }
        grid_blocks = cus * 1;
        (void)hipGetLastError();
    }
    if (grid_blocks < 0) return;
    Params p{};
    for (int i = 0; i < 25; ++i) p.in[i] = (const float*)d_in[i];
    p.pos = (const int*)d_in[2];
    p.out = (float*)d_out; p.ws = (unsigned char*)d_ws;
    void* args[] = {&p};
    hipError_t e = hipLaunchCooperativeKernel((const void*)fwd_megakernel, dim3(grid_blocks), dim3(512), args, LDS_BYTES, stream);
    if (e != hipSuccess) fprintf(stderr, "cooperative launch failed: %s (grid %d)\n", hipGetErrorString(e), grid_blocks);
}
```

```cpp
#include <hip/hip_runtime.h>
#include <hip/hip_cooperative_groups.h>
#include <cstdio>
#include <cstdint>
namespace cg = cooperative_groups;

#define LAS __attribute__((address_space(3)))
typedef _Float16 h16;
typedef _Float16 h16x8 __attribute__((ext_vector_type(8)));
typedef _Float16 h16x4 __attribute__((ext_vector_type(4)));
typedef _Float16 h16x2 __attribute__((ext_vector_type(2)));
typedef float f32x4 __attribute__((ext_vector_type(4)));
typedef float f32x2 __attribute__((ext_vector_type(2)));
typedef float f32x16 __attribute__((ext_vector_type(16)));
typedef unsigned u32x4 __attribute__((ext_vector_type(4)));

constexpr int TT = 65536, DM = 1024, SEQ = 2048, NB = 32, MEMT = 8192, FFH = 2816;
constexpr int PROJW = 1536;
constexpr float ALPHA = 1.4142135623730951f;
constexpr float QSCALE = 0.14724444602590306f;
constexpr float XQSCALE = 0.09016844005556021f;
constexpr size_t MiB = 1u << 20;
constexpr size_t WS_BIAS = 0;
constexpr size_t WS_W = 1 * MiB;
constexpr size_t WS_COS = 65 * MiB, WS_SIN = 69 * MiB, WS_SSQ = 73 * MiB;
constexpr size_t WS_MEMH = 76 * MiB, WS_XK = 92 * MiB, WS_XVT = 124 * MiB;
constexpr size_t WS_XH = 156 * MiB, WS_YCAT = 284 * MiB, WS_VT = 412 * MiB, WS_KR = 476 * MiB, WS_BIG = 480 * MiB;
constexpr size_t WS_PROJ = WS_BIG, WS_Q = WS_BIG + 224 * MiB, WS_KN = WS_BIG + 320 * MiB;
constexpr size_t WS_XQ = WS_BIG, WS_P = WS_BIG + 128 * MiB, WS_XO = WS_BIG + 256 * MiB, WS_H = WS_BIG;
constexpr size_t WS_PART = 864 * MiB;
constexpr size_t WS_CSBW = 867 * MiB;
constexpr size_t WS_ST = 868 * MiB;
constexpr size_t WS_END = 872 * MiB;
constexpr int NCS = 1792 + 1024 + 5632;
constexpr size_t WO_WIN = 0, WO_WUQ = WO_WIN + 1792 * 1024, WO_WUK = WO_WUQ + 768 * 256, WO_WUV = WO_WUK + 512 * 256,
                 WO_WO = WO_WUV + 512 * 256, WO_XWQ = WO_WO + 1024 * 1024, WO_XWKV = WO_XWQ + 1024 * 1024,
                 WO_XWO = WO_XWKV + 2048 * 1024, WO_FWIN = WO_XWO + 1024 * 1024, WO_FWD = WO_FWIN + 5632 * 1024,
                 WO_END = WO_FWD + 1024 * 2816;
static_assert(WO_END * 2 <= 32 * MiB, "weights per layer");
constexpr int LDS_STATS = 131072 + 8192 + 1024 + 64;
constexpr int LDS_COLS = LDS_STATS + 2 * 8192;
constexpr int LDS_BYTES = LDS_COLS + 2 * 2048;
constexpr size_t WS_BAR = 256 * 1024;

struct Params {
    const float* in[25];
    const int* pos;
    float* out;
    unsigned char* ws;
};

typedef const __attribute__((address_space(4))) Params* KP;
__device__ __forceinline__ KP kparams() { KP p = (KP)__builtin_amdgcn_kernarg_segment_ptr(); asm volatile("" : "+s"(p)); return p; }

__device__ __forceinline__ int tid_here() { int t = threadIdx.x; asm volatile("" : "+v"(t)); return t; }
__device__ __forceinline__ int bid_here() { int b = blockIdx.x; asm volatile("" : "+s"(b)); return b; }

__device__ __forceinline__ float wave_sum(float v) {
#pragma unroll
    for (int o = 1; o < 64; o <<= 1) v += __shfl_xor(v, o);
    return v;
}
__device__ __forceinline__ h16x4 cvt4(f32x4 v) { h16x4 r; r[0] = (h16)v[0]; r[1] = (h16)v[1]; r[2] = (h16)v[2]; r[3] = (h16)v[3]; return r; }
__device__ __forceinline__ float fast_exp2(float x) { return __builtin_amdgcn_exp2f(x); }

constexpr int BM = 256, BK = 64, HALF = 128, HTB = HALF * BK * 2, NXCD = 8, WGM = 8;
__device__ __forceinline__ int lds_byte(int r, int c) { const int st = (r >> 4) * 2 + (c >> 5), rr = r & 15, cc = c & 31, ob = rr * 64 + cc * 2; return st * 1024 + (ob ^ (((ob >> 9) & 1) << 5)); }
__device__ __forceinline__ void stage_rc(int b, int& R, int& C) { const int st = b / 1024, sb = b % 1024, swz = sb ^ (((sb >> 9) & 1) << 5); R = (st >> 1) * 16 + swz / 64; C = (st & 1) * 32 + (swz % 64) / 2; }

__device__ __forceinline__ int perm32(int rho) { const int n = rho >> 4, i = rho & 15; return 8 * (i >> 2) + 4 * n + (i & 3); }
enum { E_INPROJ = 0, E_QUP, E_KUP, E_VTUP, E_F16, E_RESID, E_SOFTMAX, E_SWIGLU, E_RESID0 };
struct GemmDesc {
    const h16* A; const h16* B; int lda, ldb, K;
    int nM, nN, nZ1, nZ2;
    int a_s1, a_s2, b_s1, b_s2;
    int epi;
    void* out; int ldc; float scale; const float* res; const float* bias;
    const float* st_in; float* st_out; const float* cs; int fold;
};
struct Unit { int row0, col0, pn; unsigned a, b; };

__device__ __forceinline__ bool unit_next(const GemmDesc& g, int i, int G, int c, Unit& u) {
    const int nwg = g.nZ1 * g.nZ2 * g.nM * g.nN;
    const long L = (long)i * G + c; if (L >= nwg) return false;
    int zb = 0, zh = 0, pm, pn;
    if (g.nZ1 * g.nZ2 == 1) {
        const int nM = g.nM, nN = g.nN;
        int wgid = (int)L; { const int q = nwg / NXCD, r = nwg % NXCD, xcd = wgid % NXCD, off = wgid / NXCD; wgid = (xcd < r ? xcd * (q + 1) : r * (q + 1) + (xcd - r) * q) + off; }
        const int nig = WGM * nN, gid = wgid / nig, fm = gid * WGM, gsz = (nM - fm) < WGM ? (nM - fm) : WGM;
        pm = fm + ((wgid % nig) % gsz); pn = (wgid % nig) / gsz;
    } else {
        int r = (int)L; pn = r % g.nN; r /= g.nN; pm = r % g.nM; r /= g.nM; zh = r % g.nZ2; zb = r / g.nZ2;
    }
    u.row0 = (zb * g.nM + pm) * BM; u.col0 = (zh * g.nN + pn) * BM; u.pn = pn;
    u.a = (unsigned)(zb * g.a_s1 + zh * g.a_s2 + pm * BM * g.lda) * 2u;
    u.b = (unsigned)(zb * g.b_s1 + zh * g.b_s2 + pn * BM * g.ldb) * 2u;
    return true;
}

__device__ __forceinline__ void row_stats(const LAS float* st, int row, float& mu, float& rstd) {
    const f32x4 a = *(const LAS f32x4*)(st + row * 8), b = *(const LAS f32x4*)(st + row * 8 + 4);
    mu = ((a[0] + a[2]) + (b[0] + b[2])) * (1.f / DM);
    const float var = ((a[1] + a[3]) + (b[1] + b[3])) * (1.f / DM) - mu * mu;
    rstd = __builtin_amdgcn_rsqf(var + 1e-5f);
}
template <int CN> __device__ __forceinline__ void fold_acc(f32x4 (&acc)[2][2][4][2], const LAS float* stl, const LAS float* ctl, int rloc, int cloc) {
    f32x4 cs[2][2], bw[2][2];
#pragma unroll
    for (int bj = 0; bj < 2; ++bj)
#pragma unroll
        for (int n = 0; n < 2; ++n) { cs[bj][n] = *(const LAS f32x4*)(ctl + cloc + bj * HALF + n * CN); bw[bj][n] = *(const LAS f32x4*)(ctl + 256 + cloc + bj * HALF + n * CN); }
#pragma unroll
    for (int ai = 0; ai < 2; ++ai)
#pragma unroll
        for (int m = 0; m < 4; ++m) { float mu, rstd; row_stats(stl, rloc + ai * HALF + m * 16, mu, rstd);
#pragma unroll
            for (int bj = 0; bj < 2; ++bj)
#pragma unroll
                for (int n = 0; n < 2; ++n) acc[ai][bj][m][n] = (acc[ai][bj][m][n] - cs[bj][n] * mu) * rstd + bw[bj][n]; }
}

#define LDS_BARRIER() asm volatile("s_waitcnt lgkmcnt(0)\n\ts_barrier" ::: "memory")
template <int EPI> __device__ __forceinline__ void epilogue(const GemmDesc& g, const Unit& u, f32x4 (&acc)[2][2][4][2], int wr, int wc, int fr, int fq,
                                         LAS unsigned char* lds, unsigned char* ws, const LAS float* stl, const LAS float* ctl) {
    const float* COS = (const float*)(ws + WS_COS); const float* SIN = (const float*)(ws + WS_SIN); float* SSQ = (float*)(ws + WS_SSQ);
    const int rbase = u.row0 + wr * 64 + fr;
    constexpr int CN = 4;
    const int cbase = u.col0 + wc * 32 + 8 * fq;
    if (EPI == E_INPROJ || EPI == E_F16 || EPI == E_SWIGLU) { if (g.fold) fold_acc<CN>(acc, stl, ctl, wr * 64 + fr, cbase - u.col0); }
    switch (EPI) {
    case E_INPROJ: {
        if (u.pn < 6) {
            h16* O = (h16*)g.out;
            f32x4 bv[2][2];
#pragma unroll
            for (int bj = 0; bj < 2; ++bj)
#pragma unroll
                for (int n = 0; n < 2; ++n) bv[bj][n] = *(const f32x4*)(g.bias + cbase + bj * HALF + n * CN);
#pragma unroll
            for (int ai = 0; ai < 2; ++ai)
#pragma unroll
                for (int m = 0; m < 4; ++m) {
                    const int row = rbase + ai * HALF + m * 16; float ss = 0.f;
#pragma unroll
                    for (int bj = 0; bj < 2; ++bj)
#pragma unroll
                        for (int n = 0; n < 2; ++n) { const f32x4 v = acc[ai][bj][m][n] + bv[bj][n]; ss += (v[0] * v[0] + v[1] * v[1]) + (v[2] * v[2] + v[3] * v[3]);
                            *(h16x4*)(O + (size_t)row * PROJW + cbase + bj * HALF + n * CN) = cvt4(v); }
                    if (u.pn < 2) { ss += __shfl_xor(ss, 16); ss += __shfl_xor(ss, 32); if (fq == 0) SSQ[(size_t)row * 8 + u.pn * 4 + wc] = ss; }
                }
        } else if (wc == 0) {
            h16* KR = (h16*)(ws + WS_KR);
            const f32x4 b0 = *(const f32x4*)(g.bias + 1536 + 4 * fq), b1 = *(const f32x4*)(g.bias + 1536 + 16 + 4 * fq);
#pragma unroll
            for (int ai = 0; ai < 2; ++ai)
#pragma unroll
                for (int m = 0; m < 4; ++m) {
                    const int row = rbase + ai * HALF + m * 16;
                    const f32x4 c = *(const f32x4*)(COS + (size_t)row * 16 + 4 * fq), s = *(const f32x4*)(SIN + (size_t)row * 16 + 4 * fq);
                    const f32x4 v0 = acc[ai][0][m][0] + b0, v1 = acc[ai][0][m][1] + b1;
                    *(h16x4*)(KR + (size_t)row * 32 + 4 * fq) = cvt4(v0 * c - v1 * s);
                    *(h16x4*)(KR + (size_t)row * 32 + 16 + 4 * fq) = cvt4(v0 * s + v1 * c);
                }
        }
    } break;
    case E_QUP: {
        h16* O = (h16*)g.out;
#pragma unroll
        for (int ai = 0; ai < 2; ++ai) {
            float scr_[4]; f32x4 cr[4], sr[4];
#pragma unroll
            for (int m = 0; m < 4; ++m) { const int row = rbase + ai * HALF + m * 16;
                const f32x4 q4 = *(const LAS f32x4*)(stl + (row - u.row0) * 8);
                scr_[m] = QSCALE * __builtin_amdgcn_rsqf(((q4[0] + q4[1]) + (q4[2] + q4[3])) * (1.f / 256.f) + 1e-6f);
                cr[m] = *(const f32x4*)(COS + (size_t)row * 16 + 4 * fq); sr[m] = *(const f32x4*)(SIN + (size_t)row * 16 + 4 * fq); }
#pragma unroll
            for (int m = 0; m < 4; ++m) {
                const int row = rbase + ai * HALF + m * 16;
                const float sc = scr_[m]; const f32x4 c = cr[m], s = sr[m];
#pragma unroll
                for (int bj = 0; bj < 2; ++bj) {
                    const int gcol = u.col0 + bj * HALF + wc * 32;
                    const f32x4 v0 = acc[ai][bj][m][0] * sc, v1 = acc[ai][bj][m][1] * sc;
                    if ((gcol >> 5) % 3 == 2) {
                        *(h16x4*)(O + (size_t)row * 768 + gcol + 4 * fq) = cvt4(v0 * c - v1 * s);
                        *(h16x4*)(O + (size_t)row * 768 + gcol + 16 + 4 * fq) = cvt4(v0 * s + v1 * c);
                    } else {
                        *(h16x4*)(O + (size_t)row * 768 + gcol + 8 * fq) = cvt4(v0);
                        *(h16x4*)(O + (size_t)row * 768 + gcol + 8 * fq + 4) = cvt4(v1);
                    }
                }
            }
        }
    } break;
    case E_KUP: {
        h16* O = (h16*)g.out;
        float scr_[2][4];
#pragma unroll
        for (int ai = 0; ai < 2; ++ai)
#pragma unroll
            for (int m = 0; m < 4; ++m) { const f32x4 q4 = *(const LAS f32x4*)(stl + (rbase - u.row0 + ai * HALF + m * 16) * 8 + 4);
                scr_[ai][m] = __builtin_amdgcn_rsqf(((q4[0] + q4[1]) + (q4[2] + q4[3])) * (1.f / 256.f) + 1e-6f); }
#pragma unroll
        for (int ai = 0; ai < 2; ++ai)
#pragma unroll
            for (int m = 0; m < 4; ++m) {
                const int row = rbase + ai * HALF + m * 16; const float sc = scr_[ai][m];
#pragma unroll
                for (int bj = 0; bj < 2; ++bj)
#pragma unroll
                    for (int n = 0; n < 2; ++n) *(h16x4*)(O + (size_t)row * 512 + cbase + bj * HALF + n * CN) = cvt4(acc[ai][bj][m][n] * sc);
            }
    } break;
    case E_VTUP: {
        h16* O = (h16*)g.out;
        f32x4 sc[2][2];
#pragma unroll
        for (int bj = 0; bj < 2; ++bj)
#pragma unroll
            for (int n = 0; n < 2; ++n)
#pragma unroll
                for (int j = 0; j < 4; ++j) { const f32x4 q4 = *(const LAS f32x4*)(stl + (cbase - u.col0 + bj * HALF + n * CN + j) * 8 + 4);
                    sc[bj][n][j] = __builtin_amdgcn_rsqf(((q4[0] + q4[1]) + (q4[2] + q4[3])) * (1.f / 256.f) + 1e-6f); }
#pragma unroll
        for (int ai = 0; ai < 2; ++ai)
#pragma unroll
            for (int m = 0; m < 4; ++m) {
                const int row = rbase + ai * HALF + m * 16;
#pragma unroll
                for (int bj = 0; bj < 2; ++bj)
#pragma unroll
                    for (int n = 0; n < 2; ++n) *(h16x4*)(O + (size_t)row * TT + cbase + bj * HALF + n * CN) = cvt4(acc[ai][bj][m][n] * sc[bj][n]);
            }
    } break;
    case E_F16: {
        h16* O = (h16*)g.out; const float sc = g.scale; const int ldc = g.ldc;
#pragma unroll
        for (int ai = 0; ai < 2; ++ai)
#pragma unroll
            for (int m = 0; m < 4; ++m) {
                const int row = rbase + ai * HALF + m * 16;
#pragma unroll
                for (int bj = 0; bj < 2; ++bj)
#pragma unroll
                    for (int n = 0; n < 2; ++n) *(h16x4*)(O + (size_t)row * ldc + cbase + bj * HALF + n * CN) = cvt4(acc[ai][bj][m][n] * sc);
            }
    } break;
    case E_RESID0:
    case E_RESID: {
        constexpr bool FOLD = (EPI == E_RESID);
        const h16* ZH = (const h16*)(ws + WS_XH); h16* ZO = (h16*)g.out;
        LAS f32x2* PP = (LAS f32x2*)(lds + 131072);
#define RS_LOAD(ZB, XB, ai_, m0_) do { _Pragma("unroll") for (int mm = 0; mm < 2; ++mm) { const size_t off_ = (size_t)(rbase + (ai_) * HALF + ((m0_) + mm) * 16) * DM + cbase; \
            _Pragma("unroll") for (int bj = 0; bj < 2; ++bj) { if (FOLD) ZB[mm][bj] = *(const h16x8*)(ZH + off_ + bj * HALF); \
                else { XB[mm][bj][0] = *(const f32x4*)(g.res + off_ + bj * HALF); XB[mm][bj][1] = *(const f32x4*)(g.res + off_ + bj * HALF + 4); } } } } while (0)
#define RS_PROC(ZB, XB, ai_, m0_) do { _Pragma("unroll") for (int mm = 0; mm < 2; ++mm) { const int m = (m0_) + mm; \
            const int row = rbase + (ai_) * HALF + m * 16; const size_t off = (size_t)row * DM + cbase; \
            float mu_ = 0.f, rstd_ = 1.f; if (FOLD) row_stats(stl, row - u.row0, mu_, rstd_); \
            const LAS float* ctr = ctl + (cbase - u.col0); asm volatile("" : "+v"(ctr)); \
            float ps = 0.f, pss = 0.f; \
            _Pragma("unroll") for (int bj = 0; bj < 2; ++bj) { h16x8 zo; \
                _Pragma("unroll") for (int n = 0; n < 2; ++n) { f32x4 x; \
                    if (FOLD) { const f32x4 gvv = *(const LAS f32x4*)(ctr + bj * HALF + n * CN), bvv = *(const LAS f32x4*)(ctr + 256 + bj * HALF + n * CN); \
                        _Pragma("unroll") for (int j = 0; j < 4; ++j) x[j] = ((float)ZB[mm][bj][4 * n + j] - mu_) * rstd_ * gvv[j] + bvv[j]; } \
                    else x = XB[mm][bj][n]; \
                    const f32x4 z = x * ALPHA + acc[ai_][bj][m][n]; \
                    ps += (z[0] + z[1]) + (z[2] + z[3]); pss += (z[0] * z[0] + z[1] * z[1]) + (z[2] * z[2] + z[3] * z[3]); \
                    _Pragma("unroll") for (int j = 0; j < 4; ++j) zo[4 * n + j] = (h16)z[j]; } \
                *(h16x8*)(ZO + off + bj * HALF) = zo; } \
            ps += __shfl_xor(ps, 16); ps += __shfl_xor(ps, 32); pss += __shfl_xor(pss, 16); pss += __shfl_xor(pss, 32); \
            if (fq == 0) PP[((ai_) * HALF + wr * 64 + m * 16 + fr) * 4 + wc] = (f32x2){ps, pss}; } } while (0)
        if (FOLD) {
            h16x8 zA[2][2], zB[2][2]; f32x4 xd[2][2][2];
            RS_LOAD(zA, xd, 0, 0); RS_LOAD(zB, xd, 0, 2);
            RS_PROC(zA, xd, 0, 0); RS_LOAD(zA, xd, 1, 0);
            RS_PROC(zB, xd, 0, 2); RS_LOAD(zB, xd, 1, 2);
            RS_PROC(zA, xd, 1, 0);
            RS_PROC(zB, xd, 1, 2);
        } else {
            h16x8 zd[2][2]; f32x4 xA[2][2][2];
#pragma unroll
            for (int ai = 0; ai < 2; ++ai)
#pragma unroll
                for (int m0 = 0; m0 < 4; m0 += 2) { RS_LOAD(zd, xA, ai, m0); RS_PROC(zd, xA, ai, m0); }
        }
#undef RS_LOAD
#undef RS_PROC
        LDS_BARRIER();
        { const int t = wr * 256 + wc * 64 + fq * 16 + fr;
          if (t < 256) { const f32x2 a = PP[t * 4 + 0], b = PP[t * 4 + 1], c = PP[t * 4 + 2], d = PP[t * 4 + 3];
              *(f32x2*)(g.st_out + (size_t)(u.row0 + t) * 8 + u.pn * 2) = (f32x2){(a[0] + b[0]) + (c[0] + d[0]), (a[1] + b[1]) + (c[1] + d[1])}; } }
    } break;
    case E_SOFTMAX: {
        h16* O = (h16*)g.out;
        LAS float* PM = (LAS float*)(lds + 131072);
        LAS float* PS = (LAS float*)(lds + 131072 + 4096);
        float mx[2][4];
#pragma unroll
        for (int ai = 0; ai < 2; ++ai)
#pragma unroll
            for (int m = 0; m < 4; ++m) {
                float v = -INFINITY;
#pragma unroll
                for (int bj = 0; bj < 2; ++bj)
#pragma unroll
                    for (int n = 0; n < 2; ++n) { const f32x4 x = acc[ai][bj][m][n]; v = fmaxf(v, fmaxf(fmaxf(x[0], x[1]), fmaxf(x[2], x[3]))); }
                v = fmaxf(v, __shfl_xor(v, 16)); v = fmaxf(v, __shfl_xor(v, 32));
                if (fq == 0) PM[(ai * HALF + wr * 64 + m * 16 + fr) * 4 + wc] = v;
            }
        LDS_BARRIER();
#pragma unroll
        for (int ai = 0; ai < 2; ++ai)
#pragma unroll
            for (int m = 0; m < 4; ++m) {
                const f32x4 p = *(const LAS f32x4*)(PM + (ai * HALF + wr * 64 + m * 16 + fr) * 4);
                const float mm = fmaxf(fmaxf(p[0], p[1]), fmaxf(p[2], p[3])); mx[ai][m] = mm; float s = 0.f;
#pragma unroll
                for (int bj = 0; bj < 2; ++bj)
#pragma unroll
                    for (int n = 0; n < 2; ++n) { f32x4 x = acc[ai][bj][m][n];
#pragma unroll
                        for (int j = 0; j < 4; ++j) { x[j] = fast_exp2(x[j] - mm); s += x[j]; }
                        acc[ai][bj][m][n] = x; }
                s += __shfl_xor(s, 16); s += __shfl_xor(s, 32);
                if (fq == 0) PS[(ai * HALF + wr * 64 + m * 16 + fr) * 4 + wc] = s;
            }
        LDS_BARRIER();
#pragma unroll
        for (int ai = 0; ai < 2; ++ai)
#pragma unroll
            for (int m = 0; m < 4; ++m) {
                const f32x4 p = *(const LAS f32x4*)(PS + (ai * HALF + wr * 64 + m * 16 + fr) * 4);
                const float inv = 1.f / ((p[0] + p[1]) + (p[2] + p[3]));
                const int row = rbase + ai * HALF + m * 16;
#pragma unroll
                for (int bj = 0; bj < 2; ++bj)
#pragma unroll
                    for (int n = 0; n < 2; ++n) *(h16x4*)(O + (size_t)row * DM + cbase + bj * HALF + n * CN) = cvt4(acc[ai][bj][m][n] * inv);
            }
        (void)mx;
    } break;
    case E_SWIGLU: {
        h16* O = (h16*)g.out;
#pragma unroll
        for (int ai = 0; ai < 2; ++ai)
#pragma unroll
            for (int m = 0; m < 4; ++m) {
                const int row = rbase + ai * HALF + m * 16;
#pragma unroll
                for (int n = 0; n < 2; ++n) { const f32x4 gt = acc[ai][0][m][n], up = acc[ai][1][m][n]; f32x4 hv;
#pragma unroll
                    for (int j = 0; j < 4; ++j) hv[j] = gt[j] * __builtin_amdgcn_rcpf(1.f + fast_exp2(gt[j] * -1.4426950408889634f)) * up[j];
                    *(h16x4*)(O + (size_t)row * FFH + u.pn * HALF + (cbase - u.col0) + n * CN) = cvt4(hv); }
            }
    } break;
    default: break;
    }
}

template <int EPI> __device__ __forceinline__ void gemm_run(LAS unsigned char* lds, const GemmDesc& g, unsigned char* ws) {
    const int tid = tid_here(), wid = __builtin_amdgcn_readfirstlane(tid >> 6), lane = tid & 63, wr = wid >> 2, wc = wid & 3, fr = lane & 15, fq = lane >> 4;
    LAS int* utab = (LAS int*)(lds + 131072 + 8192);
    if (tid < 32) { Unit u; const bool ok = unit_next(g, tid, gridDim.x, bid_here(), u);
        utab[tid * 8 + 0] = ok ? u.row0 : -1; utab[tid * 8 + 1] = u.col0; utab[tid * 8 + 2] = u.pn; utab[tid * 8 + 3] = (int)u.a; utab[tid * 8 + 4] = (int)u.b; }
    __syncthreads();
#define UT(i, f) __builtin_amdgcn_readfirstlane(utab[(i) * 8 + (f)])
    const int nt = g.K / BK;
    const char* const gA = (const char*)g.A; const char* const gB = (const char*)g.B;
    unsigned voffA[2], voffB[2];
#pragma unroll
    for (int i = 0; i < 2; ++i) { int R, C; stage_rc(tid * 16 + i * 8192, R, C); const int Rb = (R & ~31) + perm32(R & 31);
        voffA[i] = (unsigned)(R * g.lda + C) * 2u; voffB[i] = (unsigned)(Rb * g.ldb + C) * 2u; }
    const unsigned kstep = (unsigned)(BK * 2);
    const unsigned hstepA = (unsigned)HALF * g.lda * 2u, hstepB = (unsigned)HALF * g.ldb * 2u;
    const unsigned ldsw = (unsigned)wid * 1024u;
    const int aoff = lds_byte(wr * 64 + fr, fq * 8), boff = lds_byte(wc * 32 + fr, fq * 8);
#define SA(b, h) (((b) * 2 + (h)) * HTB)
#define SB(b, h) ((4 + (b) * 2 + (h)) * HTB)
#define STAGE(bufoff, gbase, soff, voff) do { _Pragma("unroll") for (int _i = 0; _i < 2; ++_i) \
        __builtin_amdgcn_global_load_lds((const unsigned*)((gbase) + (size_t)((soff) + (voff)[_i])), (LAS unsigned*)(lds + (bufoff) + ldsw + _i * 8192), 16, 0, 0); } while (0)
#define LDA(dst, b, h) do { _Pragma("unroll") for (int m = 0; m < 4; ++m) _Pragma("unroll") for (int k = 0; k < 2; ++k) dst[m][k] = *(const LAS h16x8*)(lds + SA(b, h) + aoff + m * 2048 + k * 1024); } while (0)
#define LDB(dst, b, h) do { _Pragma("unroll") for (int n = 0; n < 2; ++n) _Pragma("unroll") for (int k = 0; k < 2; ++k) dst[n][k] = *(const LAS h16x8*)(lds + SB(b, h) + boff + n * 2048 + k * 1024); } while (0)
#define MMA(ai, bj, At, Bt) do { __builtin_amdgcn_s_setprio(1); _Pragma("unroll") for (int m = 0; m < 4; ++m) _Pragma("unroll") for (int n = 0; n < 2; ++n) _Pragma("unroll") for (int k = 0; k < 2; ++k) \
        acc[ai][bj][m][n] = __builtin_amdgcn_mfma_f32_16x16x32_f16(Bt[n][k], At[m][k], acc[ai][bj][m][n], 0, 0, 0); __builtin_amdgcn_s_setprio(0); } while (0)
#define WAIT_V(n) asm volatile("s_waitcnt vmcnt(" #n ")" ::: "memory")
#define WAIT_L(n) asm volatile("s_waitcnt lgkmcnt(" #n ")" ::: "memory")
#define BAR __builtin_amdgcn_s_barrier()
#define SCHED __builtin_amdgcn_sched_barrier(0)
    Unit cur; int ui = 0;
    cur.row0 = UT(0, 0);
    if (cur.row0 < 0) return;
    cur.col0 = UT(0, 1); cur.pn = UT(0, 2); cur.a = (unsigned)UT(0, 3); cur.b = (unsigned)UT(0, 4);
    f32x4 acc[2][2][4][2];
#pragma unroll
    for (int a = 0; a < 2; ++a)
#pragma unroll
        for (int b = 0; b < 2; ++b)
#pragma unroll
            for (int m = 0; m < 4; ++m)
#pragma unroll
                for (int n = 0; n < 2; ++n) acc[a][b][m][n] = (f32x4){0.f, 0.f, 0.f, 0.f};
    h16x8 At[4][2], B0[2][2], B1[2][2];
    unsigned cA = cur.a, cB = cur.b;
    const bool use_ct = (EPI == E_RESID) || ((EPI == E_INPROJ || EPI == E_F16 || EPI == E_SWIGLU) && g.fold);
    const bool use_st = use_ct || EPI == E_QUP || EPI == E_KUP || EPI == E_VTUP;
    const float* const stsrc = (EPI == E_QUP || EPI == E_KUP || EPI == E_VTUP) ? (const float*)(ws + WS_SSQ) : g.st_in;
    const float* const ctA = (EPI == E_RESID) ? g.res : g.cs; const float* const ctB = (EPI == E_RESID) ? g.bias : g.cs + 2 * NCS;
#define STATS_DMA(r0, sel) __builtin_amdgcn_global_load_lds((const unsigned*)(stsrc + (size_t)((r0) + wid * 32 + (lane >> 1)) * 8 + (lane & 1) * 4), (LAS unsigned*)(lds + LDS_STATS + (sel) * 8192 + wid * 1024), 16, 0, 0)
#define COLS_DMA(c0, sel) __builtin_amdgcn_global_load_lds((const unsigned*)((wid == 0 ? ctA : ctB) + (c0) + lane * 4), (LAS unsigned*)(lds + LDS_COLS + (sel) * 2048 + wid * 1024), 16, 0, 0)
    if (use_st) STATS_DMA((EPI == E_VTUP) ? cur.col0 : cur.row0, 0);
    if (use_ct && wid < 2) COLS_DMA(cur.col0, 0);
    STAGE(SB(0, 0), gB, cB, voffB); STAGE(SB(0, 1), gB, cB + hstepB, voffB); STAGE(SA(0, 0), gA, cA, voffA); STAGE(SA(0, 1), gA, cA + hstepA, voffA);
    if (wr == 1) BAR;
    WAIT_V(2); BAR;
    STAGE(SB(1, 0), gB, cB + kstep, voffB); STAGE(SA(1, 0), gA, cA + kstep, voffA); STAGE(SB(1, 1), gB, cB + hstepB + kstep, voffB);
    WAIT_V(6); BAR;
    for (;;) {
        const int nrow0 = (ui + 1 < 32) ? UT(ui + 1, 0) : -1;
        const bool has_next = nrow0 >= 0;
        const unsigned nA = has_next ? (unsigned)UT(ui + 1, 3) : cA, nB = has_next ? (unsigned)UT(ui + 1, 4) : cB;
        for (int t = 0; t < nt; t += 2) {
            const bool last = (t == nt - 2);
            const unsigned a1 = cA + (unsigned)(t + 1) * kstep;
            const unsigned a2 = last ? nA : cA + (unsigned)(t + 2) * kstep, b2 = last ? nB : cB + (unsigned)(t + 2) * kstep;
            const unsigned a3 = a2 + kstep, b3 = b2 + kstep;
            LDB(B0, 0, 0); LDB(B1, 0, 1); SCHED; LDA(At, 0, 0); STAGE(SA(1, 1), gA, a1 + hstepA, voffA);
            WAIT_V(8); WAIT_L(0); BAR; MMA(0, 0, At, B0); MMA(0, 1, At, B1); BAR; SCHED;
            LDA(At, 0, 1); STAGE(SB(0, 0), gB, b2, voffB); STAGE(SB(0, 1), gB, b2 + hstepB, voffB); STAGE(SA(0, 0), gA, a2, voffA);
            WAIT_V(8); WAIT_L(0); BAR; MMA(1, 0, At, B0); MMA(1, 1, At, B1); BAR; SCHED;
            LDB(B0, 1, 0); LDB(B1, 1, 1); SCHED; LDA(At, 1, 0); STAGE(SA(0, 1), gA, a2 + hstepA, voffA);
            WAIT_V(8); WAIT_L(0); BAR; MMA(0, 0, At, B0); MMA(0, 1, At, B1); BAR; SCHED;
            LDA(At, 1, 1); STAGE(SB(1, 0), gB, b3, voffB); STAGE(SB(1, 1), gB, b3 + hstepB, voffB); STAGE(SA(1, 0), gA, a3, voffA);
            WAIT_V(8); WAIT_L(0); BAR; MMA(1, 0, At, B0); MMA(1, 1, At, B1); BAR; SCHED;
        }
        if (wr == 0) BAR;
        epilogue<EPI>(g, cur, acc, wr, wc, fr, fq, lds, ws, (const LAS float*)(lds + LDS_STATS + (ui & 1) * 8192), (const LAS float*)(lds + LDS_COLS + (ui & 1) * 2048));
        if (has_next) { if (use_st) STATS_DMA((EPI == E_VTUP) ? UT(ui + 1, 1) : nrow0, (ui + 1) & 1); if (use_ct && wid < 2) COLS_DMA(UT(ui + 1, 1), (ui + 1) & 1); }
        if (!has_next) break;
#pragma unroll
        for (int a = 0; a < 2; ++a)
#pragma unroll
            for (int b = 0; b < 2; ++b)
#pragma unroll
                for (int m = 0; m < 4; ++m)
#pragma unroll
                    for (int n = 0; n < 2; ++n) acc[a][b][m][n] = (f32x4){0.f, 0.f, 0.f, 0.f};
        ++ui;
        cur.row0 = nrow0; cur.col0 = UT(ui, 1); cur.pn = UT(ui, 2); cur.a = nA; cur.b = nB; cA = nA; cB = nB;
        if (wr == 1) BAR;
    }
    WAIT_V(0);
    BAR;
#undef STATS_DMA
#undef COLS_DMA
#undef UT
#undef SA
#undef SB
#undef STAGE
#undef LDA
#undef LDB
#undef MMA
#undef WAIT_V
#undef WAIT_L
#undef BAR
#undef SCHED
}

__device__ const double INV_FREQ[16] = {1.0, 0.5623413251903491, 0.31622776601683794, 0.1778279410038923, 0.1, 0.05623413251903491, 0.03162277660168379,
    0.01778279410038923, 0.01, 0.005623413251903491, 0.0031622776601683794, 0.0017782794100389228, 0.001, 0.0005623413251903491, 0.00031622776601683794, 0.00017782794100389227};

__device__ __forceinline__ void transpose_item(const float* W, int K, int N, h16* WT, int drow, bool rperm, const float* kscale, const float* kbias, float* part, LAS float* scr, int k0, int n0, int lane) {
    { float wv[32];
#pragma unroll
      for (int i = 0; i < 32; ++i) wv[i] = W[(size_t)(k0 + 2 * i + (lane >> 5)) * N + n0 + (lane & 31)];
#pragma unroll
      for (int i = 0; i < 32; ++i) scr[(2 * i + (lane >> 5)) * 33 + (lane & 31)] = wv[i]; }
    asm volatile("s_waitcnt lgkmcnt(0)" ::: "memory");
    const int c = lane & 7;
    float sc[8];
#pragma unroll
    for (int e = 0; e < 8; ++e) sc[e] = kscale ? kscale[k0 + 8 * c + e] : 1.f;
#pragma unroll
    for (int j = 0; j < 4; ++j) { const int n = (lane >> 3) + 8 * j; const LAS float* s = scr + (8 * c) * 33 + n;
        h16x8 o;
#pragma unroll
        for (int e = 0; e < 8; ++e) o[e] = (h16)(s[e * 33] * sc[e]);
        *(h16x8*)(WT + (size_t)(drow + (rperm ? perm32(n) : n)) * K + k0 + 8 * c) = o; }
    if (part) {
        const float myks = kscale[k0 + lane], mykb = kbias[k0 + lane];
        float a = 0.f, b = 0.f; const int n = lane & 31, kh = (lane >> 5) * 32;
#pragma unroll
        for (int kk = 0; kk < 32; ++kk) { const float w = scr[(kh + kk) * 33 + n];
            a += w * __shfl(myks, kh + kk); b += w * __shfl(mykb, kh + kk); }
        a += __shfl_xor(a, 32); b += __shfl_xor(b, 32);
        if (lane < 32) *(f32x2*)(part + ((size_t)(drow + (rperm ? perm32(lane) : lane)) * 16 + (k0 >> 6)) * 2) = (f32x2){a, b};
    }
    asm volatile("s_waitcnt lgkmcnt(0)" ::: "memory");
}

__device__ __forceinline__ void prologue(LAS unsigned char* lds, KP P) {
    const int tid = tid_here(), lane = tid & 63, wave = tid >> 6, bid = bid_here();
    const int G = gridDim.x, gw = bid * 8 + wave, NGW = G * 8;
    const long gt = (long)bid * 512 + tid, NGT = (long)G * 512;
    LAS float* scr = (LAS float*)(lds + wave * 16384);
    constexpr int NJ = 9;
    const int jK[NJ] = {1024, 256, 256, 1024, 1024, 1024, 1024, 1024, 2816};
    const int jN[NJ] = {1568, 768, 1024, 1024, 1024, 2048, 1024, 5632, 1024};
    const int jin[NJ] = {3, 6, 8, 13, 16, 17, 18, 21, 22};
    const size_t jdst[NJ] = {WO_WIN, WO_WUQ, WO_WUK, WO_WO, WO_XWQ, WO_XWKV, WO_XWO, WO_FWIN, WO_FWD};
    int items_per_layer = 0;
#pragma unroll
    for (int j = 0; j < NJ; ++j) items_per_layer += (jK[j] / 64) * (jN[j] / 32);
    for (int it = gw; it < 2 * items_per_layer; it += NGW) {
        const int l = it / items_per_layer; int r = it % items_per_layer; int j = 0;
#pragma unroll
        for (int jj = 0; jj < NJ - 1; ++jj) { const int cnt = (jK[jj] / 64) * (jN[jj] / 32); if (j == jj && r >= cnt) { r -= cnt; j = jj + 1; } }
        int K = 0, N = 0, ini = 0; size_t dsto = 0;
#pragma unroll
        for (int jj = 0; jj < NJ; ++jj) if (j == jj) { K = jK[jj]; N = jN[jj]; ini = jin[jj]; dsto = jdst[jj]; }
        const int nblk = N / 32, kb = r / nblk, nb = r % nblk, n0 = nb * 32;
        int drow = n0; const float* ks = nullptr; const float* kbs = nullptr; float* part = nullptr; bool rperm = false;
        float* partl = (float*)(P->ws + WS_PART) + (size_t)l * NCS * 32;
        if (j == 0) { drow = n0 < 512 ? n0 : (n0 < 544 ? 1536 + (n0 - 512) : n0 - 32); rperm = (n0 == 512); if (l > 0) { ks = P->in[23] + (l - 1) * DM; kbs = P->in[24] + (l - 1) * DM; part = partl; } }
        else if (j == 4) { ks = P->in[14] + l * DM; kbs = P->in[15] + l * DM; part = partl + (size_t)1792 * 32; }
        else if (j == 1) { ks = P->in[5] + l * 256; rperm = (nb % 3 == 2); }
        else if (j == 2) { const int h = nb >> 2, part = nb & 3; drow = part < 2 ? h * 64 + 32 * part : 512 + h * 64 + 32 * (part - 2); ks = P->in[7] + l * 256; }
        else if (j == 7) { const int jj = n0 < FFH ? n0 : n0 - FFH; drow = (jj >> 7) * 256 + (jj & 127) + (n0 < FFH ? 0 : 128); ks = P->in[19] + l * DM; kbs = P->in[20] + l * DM; part = partl + (size_t)(1792 + 1024) * 32; }
        transpose_item(P->in[ini] + (size_t)l * K * N, K, N, (h16*)(P->ws + WS_W + (size_t)l * 32 * MiB) + dsto, drow, rperm, ks, kbs, part, scr, kb * 64, n0, lane);
    }
    for (long i = gt; i < 2L * 224 * 1024 / 8; i += NGT) { const int l = (int)(i / (224 * 1024 / 8)); const long r = i % (224 * 1024 / 8);
        unsigned zz = 0; asm volatile("" : "+v"(zz));
        *(u32x4*)((h16*)(P->ws + WS_W + (size_t)l * 32 * MiB) + WO_WIN + (size_t)1568 * 1024 + r * 8) = (u32x4){zz, zz, zz, zz}; }
    for (long i = gt; i < 2 * 1792; i += NGT) { const int l = (int)(i / 1792), r = (int)(i % 1792);
        const int src = r < 512 ? r : (r < 1536 ? r + 32 : (r < 1568 ? 512 + (r - 1536) : -1));
        ((float*)(P->ws + WS_BIAS))[i] = src >= 0 ? P->in[4][l * 1568 + src] : 0.f; }
    for (long i = gt; i < (long)TT * 16; i += NGT) { const int tok = (int)(i >> 4), f = (int)(i & 15);
        const double ang = (double)P->pos[tok] * INV_FREQ[f];
        const double kq = __builtin_rint(ang * 0.6366197723675814); const double r = (ang - kq * 1.5707963267948966) - kq * 6.123233995736766e-17;
        const double r2 = r * r;
        const double sn = r * (1.0 + r2 * (-1.0 / 6 + r2 * (1.0 / 120 + r2 * (-1.0 / 5040 + r2 * (1.0 / 362880 + r2 * (-1.0 / 39916800))))));
        const double cs = 1.0 + r2 * (-0.5 + r2 * (1.0 / 24 + r2 * (-1.0 / 720 + r2 * (1.0 / 40320 + r2 * (-1.0 / 3628800 + r2 * (1.0 / 479001600))))));
        const int q = (int)((long long)kq & 3);
        const double c = q == 0 ? cs : (q == 1 ? -sn : (q == 2 ? -cs : sn));
        const double s = q == 0 ? sn : (q == 1 ? cs : (q == 2 ? -sn : -cs));
        ((float*)(P->ws + WS_COS))[i] = (float)c; ((float*)(P->ws + WS_SIN))[i] = (float)s; }
    {
        const long n8x = (long)TT * DM / 8, n8m = (long)MEMT * DM / 8;
        for (int pass = 0; pass < 2; ++pass) {
            const f32x4* src = (const f32x4*)(pass == 0 ? P->in[0] : P->in[1]); h16x8* dst = (h16x8*)(P->ws + (pass == 0 ? WS_XH : WS_MEMH)); const long n8 = pass == 0 ? n8x : n8m;
            for (long i = gt; i < n8; i += 4 * NGT) {
                f32x4 a[4], b[4];
#pragma unroll
                for (int q = 0; q < 4; ++q) { const long ii = i + q * NGT; if (ii < n8) { a[q] = src[2 * ii]; b[q] = src[2 * ii + 1]; } }
#pragma unroll
                for (int q = 0; q < 4; ++q) { const long ii = i + q * NGT; if (ii < n8) { h16x8 o; o[0] = (h16)a[q][0]; o[1] = (h16)a[q][1]; o[2] = (h16)a[q][2]; o[3] = (h16)a[q][3]; o[4] = (h16)b[q][0]; o[5] = (h16)b[q][1]; o[6] = (h16)b[q][2]; o[7] = (h16)b[q][3]; dst[ii] = o; } }
            }
        }
    }
}

__device__ __forceinline__ void csbw_finalize(KP P) {
    const long gt = (long)bid_here() * 512 + tid_here(), NGT = (long)gridDim.x * 512;
    const float* part = (const float*)(P->ws + WS_PART); float* cs = (float*)(P->ws + WS_CSBW);
    for (long i = gt; i < 2L * NCS; i += NGT) { const int c = (int)(i % NCS); float a = 0.f, b = 0.f;
        if (!(c >= 1568 && c < 1792) && !(i < 1792)) {
            const f32x2* p = (const f32x2*)part + i * 16;
#pragma unroll
            for (int k = 0; k < 16; ++k) { const f32x2 v = p[k]; a += v[0]; b += v[1]; } }
        cs[i] = a; cs[2 * NCS + i] = b; }
}
__device__ __forceinline__ void ln_final(KP P, const float* gam, const float* bet) {
    const int tid = tid_here(), lane = tid & 63, wave = tid >> 6;
    const int gw = bid_here() * 8 + wave, NGW = gridDim.x * 8;
    f32x4 gv[4], bv[4];
#pragma unroll
    for (int j = 0; j < 2; ++j) { gv[2 * j] = ((const f32x4*)gam)[128 * j + 2 * lane]; gv[2 * j + 1] = ((const f32x4*)gam)[128 * j + 2 * lane + 1];
                                  bv[2 * j] = ((const f32x4*)bet)[128 * j + 2 * lane]; bv[2 * j + 1] = ((const f32x4*)bet)[128 * j + 2 * lane + 1]; }
    h16x8 z[2][2], zn[2][2];
#define LN_LOAD(dst, r0) do { _Pragma("unroll") for (int r = 0; r < 2; ++r) _Pragma("unroll") for (int j = 0; j < 2; ++j) \
        dst[r][j] = ((const h16x8*)((const h16*)(P->ws + WS_XH) + (size_t)((r0) + r) * DM))[64 * j + lane]; } while (0)
    if (gw * 2 < TT) LN_LOAD(z, gw * 2);
    for (int row0 = gw * 2; row0 < TT; row0 += NGW * 2) {
        const bool more = row0 + NGW * 2 < TT;
        if (more) LN_LOAD(zn, row0 + NGW * 2);
#pragma unroll
        for (int r = 0; r < 2; ++r) {
            f32x4 v[4]; float s = 0.f;
#pragma unroll
            for (int j = 0; j < 2; ++j) { v[2 * j] = (f32x4){(float)z[r][j][0], (float)z[r][j][1], (float)z[r][j][2], (float)z[r][j][3]}; v[2 * j + 1] = (f32x4){(float)z[r][j][4], (float)z[r][j][5], (float)z[r][j][6], (float)z[r][j][7]}; }
#pragma unroll
            for (int j = 0; j < 4; ++j) s += (v[j][0] + v[j][1]) + (v[j][2] + v[j][3]);
            const float mean = wave_sum(s) * (1.f / DM); float s2 = 0.f;
#pragma unroll
            for (int j = 0; j < 4; ++j) { v[j] = v[j] - mean; s2 += (v[j][0] * v[j][0] + v[j][1] * v[j][1]) + (v[j][2] * v[j][2] + v[j][3] * v[j][3]); }
            const float rstd = 1.f / sqrtf(wave_sum(s2) * (1.f / DM) + 1e-5f);
            f32x4* xr = (f32x4*)(P->out + (size_t)(row0 + r) * DM);
#pragma unroll
            for (int j = 0; j < 2; ++j) { xr[128 * j + 2 * lane] = v[2 * j] * rstd * gv[2 * j] + bv[2 * j]; xr[128 * j + 2 * lane + 1] = v[2 * j + 1] * rstd * gv[2 * j + 1] + bv[2 * j + 1]; }
        }
        if (more) {
#pragma unroll
            for (int r = 0; r < 2; ++r)
#pragma unroll
                for (int j = 0; j < 2; ++j) z[r][j] = zn[r][j]; }
    }
#undef LN_LOAD
}

__device__ __forceinline__ void conv_phase(LAS unsigned char* lds, KP P, int l) {
    const int tid = tid_here(), lane = tid & 63, wave = tid >> 6;
    const h16* PROJ = (const h16*)(P->ws + WS_PROJ); h16* YC = (h16*)(P->ws + WS_YCAT);
    LAS unsigned* hp = (LAS unsigned*)lds;
    LAS float* cb = (LAS float*)(lds + 65536);
    h16x2 wE[16], wO[16];
    { float w[31];
#pragma unroll
      for (int j = 0; j < 31; ++j) w[j] = P->in[9][(size_t)l * 31 * 512 + j * 512 + tid];
#pragma unroll
      for (int i = 0; i < 15; ++i) { wE[i] = (h16x2){(h16)w[2 * i], (h16)w[2 * i + 1]}; wO[i + 1] = (h16x2){(h16)w[2 * i + 1], (h16)w[2 * i + 2]}; }
      wE[15] = (h16x2){(h16)w[30], (h16)0.f}; wO[0] = (h16x2){(h16)0.f, (h16)w[0]}; }
    const float bias = P->in[10][l * 512 + tid];
    f32x4 ng[2], nbv[2];
#pragma unroll
    for (int j = 0; j < 2; ++j) { ng[j] = *(const f32x4*)(P->in[11] + l * 512 + lane * 8 + 4 * j); nbv[j] = *(const f32x4*)(P->in[12] + l * 512 + lane * 8 + 4 * j); }
    h16x8 ra0[4], rg0[4], ra1[4], rg1[4];
#define CONV_LOAD(uu) do { const int b_ = (uu) >> 6, t0_ = ((uu) & 63) * 32; \
        _Pragma("unroll") for (int k_ = 0; k_ < 4; ++k_) { const int idx_ = tid + 512 * k_; const int pr_ = idx_ >> 6, c8_ = idx_ & 63, tok_ = t0_ - 30 + 2 * pr_; \
            if (idx_ < 31 * 64 && tok_ >= 0) { const h16* src_ = PROJ + (size_t)(b_ * SEQ + tok_) * PROJW + 512 + c8_ * 8; \
                ra0[k_] = *(const h16x8*)src_; rg0[k_] = *(const h16x8*)(src_ + 512); ra1[k_] = *(const h16x8*)(src_ + PROJW); rg1[k_] = *(const h16x8*)(src_ + PROJW + 512); } } } while (0)
#define CONV_GLU(uu) do { const int t0_ = ((uu) & 63) * 32; \
        _Pragma("unroll") for (int k_ = 0; k_ < 4; ++k_) { const int idx_ = tid + 512 * k_; const int pr_ = idx_ >> 6, c8_ = idx_ & 63, tok_ = t0_ - 30 + 2 * pr_; \
            if (idx_ < 31 * 64) { u32x4 d0_ = {0u, 0u, 0u, 0u}, d1_ = {0u, 0u, 0u, 0u}; \
                if (tok_ >= 0) { \
                    _Pragma("unroll") for (int e = 0; e < 8; ++e) { \
                        const float h0_ = (float)ra0[k_][e] * __builtin_amdgcn_rcpf(1.f + fast_exp2((float)rg0[k_][e] * -1.4426950408889634f)); \
                        const float h1_ = (float)ra1[k_][e] * __builtin_amdgcn_rcpf(1.f + fast_exp2((float)rg1[k_][e] * -1.4426950408889634f)); \
                        const h16x2 pk_ = {(h16)h0_, (h16)h1_}; const unsigned w_ = __builtin_bit_cast(unsigned, pk_); \
                        if (e < 4) d0_[e] = w_; else d1_[e - 4] = w_; } } \
                *(LAS u32x4*)(hp + pr_ * 512 + c8_ * 8) = d0_; *(LAS u32x4*)(hp + pr_ * 512 + c8_ * 8 + 4) = d1_; } } } while (0)
    const int u_first = bid_here();
    if (u_first < TT / 32) { CONV_LOAD(u_first); CONV_GLU(u_first); }
    LDS_BARRIER();
    for (int u = u_first; u < TT / 32; u += gridDim.x) {
        const int b = u >> 6, t0 = (u & 63) * 32;
        const int un = u + gridDim.x; const bool has_next = un < TT / 32;
        if (has_next) CONV_LOAD(un);
        for (int m = 0; m < 16; ++m) {
            float a0 = bias, a1 = bias;
#pragma unroll
            for (int i = 0; i < 16; ++i) { const h16x2 p = __builtin_bit_cast(h16x2, hp[(m + i) * 512 + tid]);
                a0 = __builtin_amdgcn_fdot2(p, wE[i], a0, false); a1 = __builtin_amdgcn_fdot2(p, wO[i], a1, false); }
            cb[(2 * m) * 512 + tid] = a0; cb[(2 * m + 1) * 512 + tid] = a1;
        }
        LDS_BARRIER();
        if (has_next) CONV_GLU(un);
#pragma unroll
        for (int k = 0; k < 4; ++k) {
            const int lt = wave * 4 + k;
            f32x4 v0 = *(const LAS f32x4*)(cb + lt * 512 + lane * 8), v1 = *(const LAS f32x4*)(cb + lt * 512 + lane * 8 + 4);
            const float mean = wave_sum((v0[0] + v0[1]) + (v0[2] + v0[3]) + (v1[0] + v1[1]) + (v1[2] + v1[3])) * (1.f / 512.f);
            v0 = v0 - mean; v1 = v1 - mean;
            const float var = wave_sum((v0[0] * v0[0] + v0[1] * v0[1]) + (v0[2] * v0[2] + v0[3] * v0[3]) + (v1[0] * v1[0] + v1[1] * v1[1]) + (v1[2] * v1[2] + v1[3] * v1[3])) * (1.f / 512.f);
            const float rstd = 1.f / sqrtf(var + 1e-5f);
            v0 = v0 * rstd * ng[0] + nbv[0]; v1 = v1 * rstd * ng[1] + nbv[1];
            h16x8 o;
#pragma unroll
            for (int e = 0; e < 4; ++e) { o[e] = (h16)(v0[e] * __builtin_amdgcn_rcpf(1.f + fast_exp2(v0[e] * -1.4426950408889634f))); o[4 + e] = (h16)(v1[e] * __builtin_amdgcn_rcpf(1.f + fast_exp2(v1[e] * -1.4426950408889634f))); }
            *(h16x8*)(YC + (size_t)(b * SEQ + t0 + lt) * DM + 512 + lane * 8) = o;
        }
        LDS_BARRIER();
    }
#undef CONV_LOAD
#undef CONV_GLU
}

constexpr int KPITCH = 208, VPITCH = 264;
__device__ __forceinline__ void attn_phase(LAS unsigned char* lds, KP P) {
    const int tid = tid_here(), lane = tid & 63, r32 = lane & 31, hi = lane >> 5; const int wid = __builtin_amdgcn_readfirstlane(tid >> 6);
    const h16* Q = (const h16*)(P->ws + WS_Q); const h16* KN = (const h16*)(P->ws + WS_KN); const h16* KR = (const h16*)(P->ws + WS_KR);
    const h16* VT = (const h16*)(P->ws + WS_VT); h16* YC = (h16*)(P->ws + WS_YCAT);
    LAS unsigned char* Kb = lds; LAS unsigned char* Vb = lds + 2 * 128 * KPITCH; LAS unsigned char* Sg = lds + 2 * 128 * KPITCH + 2 * 64 * VPITCH + wid * (32 * 144);
    u32x4 sk[3], sv[2];
#define LOADT(J, rowbase_, h_) do { const size_t kb_ = (rowbase_) + 128 * (J); \
        _Pragma("unroll") for (int i_ = 0; i_ < 3; ++i_) { const int c_ = tid + 512 * i_, kr_ = c_ / 12, kc_ = c_ % 12; \
            sk[i_] = kc_ < 8 ? *(const u32x4*)(KN + (kb_ + kr_) * 512 + (h_) * 64 + kc_ * 8) : *(const u32x4*)(KR + (kb_ + kr_) * 32 + (kc_ - 8) * 8); } \
        _Pragma("unroll") for (int i_ = 0; i_ < 2; ++i_) { const int c_ = tid + 512 * i_; \
            sv[i_] = *(const u32x4*)(VT + (size_t)((h_) * 64 + (c_ >> 4)) * TT + kb_ + (c_ & 15) * 8); } } while (0)
#define STORET(buf) do { \
        _Pragma("unroll") for (int i_ = 0; i_ < 3; ++i_) { const int c_ = tid + 512 * i_, kr_ = c_ / 12, kc_ = c_ % 12; \
            *(LAS u32x4*)(Kb + (buf) * 128 * KPITCH + kr_ * KPITCH + kc_ * 16) = sk[i_]; } \
        _Pragma("unroll") for (int i_ = 0; i_ < 2; ++i_) { const int c_ = tid + 512 * i_; LAS unsigned char* vd_ = Vb + (buf) * 64 * VPITCH + (c_ >> 4) * VPITCH + (c_ & 15) * 16; \
            *(LAS unsigned long long*)vd_ = ((unsigned long long)sv[i_][1] << 32) | sv[i_][0]; \
            *(LAS unsigned long long*)(vd_ + 8) = ((unsigned long long)sv[i_][3] << 32) | sv[i_][2]; } } while (0)
#define LOADQ(dst, u_) do { const int bh_ = (u_) & 255, qb_ = 7 - ((u_) >> 8); \
        const h16* qp_ = Q + ((size_t)(bh_ >> 3) * SEQ + qb_ * 256 + wid * 32 + r32) * 768 + (bh_ & 7) * 96 + 8 * hi; \
        _Pragma("unroll") for (int d0 = 0; d0 < 6; ++d0) dst[d0] = *(const h16x8*)(qp_ + 16 * d0); } while (0)
    h16x8 qf[6];
    const int u_first = bid_here();
    if (u_first < 2048) { LOADQ(qf, u_first); LOADT(0, (size_t)((u_first & 255) >> 3) * SEQ, (u_first & 255) & 7); STORET(0); }
    LDS_BARRIER();
    for (int u = u_first; u < 2048; u += gridDim.x) {
        const int bh = u & 255, qb = 7 - (u >> 8), b = bh >> 3, h = bh & 7;
        const size_t rowbase = (size_t)b * SEQ; const int q0 = qb * 256, NT2 = 2 * qb + 2, my_last = 4 * qb + (wid >> 1);
        const int un = u + gridDim.x; const bool has_next = un < 2048;
        const size_t rowbase_n = (size_t)((un & 255) >> 3) * SEQ; const int h_n = (un & 255) & 7;
        f32x16 o0, o1; float m_run = -INFINITY, lsum = 0.f;
#pragma unroll
        for (int r = 0; r < 16; ++r) { o0[r] = 0.f; o1[r] = 0.f; }
        auto compute = [&](const LAS unsigned char* kbase, const LAS unsigned char* vbase) {
                f32x16 p0, p1;
#pragma unroll
                for (int r = 0; r < 16; ++r) { p0[r] = 0.f; p1[r] = 0.f; }
                const LAS unsigned char* kp = kbase + r32 * KPITCH + hi * 16;
                const LAS unsigned char* vp = vbase + r32 * VPITCH + hi * 8;
                h16x8 kf[12];
#pragma unroll
                for (int d0 = 0; d0 < 6; ++d0) { kf[2 * d0] = *(const LAS h16x8*)(kp + d0 * 32); kf[2 * d0 + 1] = *(const LAS h16x8*)(kp + 32 * KPITCH + d0 * 32); }
                __builtin_amdgcn_sched_barrier(0);
#pragma unroll
                for (int d0 = 0; d0 < 6; ++d0) {
                    p0 = __builtin_amdgcn_mfma_f32_32x32x16_f16(kf[2 * d0], qf[d0], p0, 0, 0, 0);
                    p1 = __builtin_amdgcn_mfma_f32_32x32x16_f16(kf[2 * d0 + 1], qf[d0], p1, 0, 0, 0);
                }
                h16x4 vf[4][4];
#pragma unroll
                for (int t = 0; t < 4; ++t) { const int kbyte = (32 * (t >> 1) + 16 * (t & 1)) * 2;
                    vf[t][0] = *(const LAS h16x4*)(vp + kbyte); vf[t][1] = *(const LAS h16x4*)(vp + kbyte + 16);
                    vf[t][2] = *(const LAS h16x4*)(vp + 32 * VPITCH + kbyte); vf[t][3] = *(const LAS h16x4*)(vp + 32 * VPITCH + kbyte + 16); }
                __builtin_amdgcn_sched_barrier(0);
                float mx = fmaxf(p0[0], p1[0]);
#pragma unroll
                for (int r = 1; r < 16; ++r) mx = fmaxf(mx, fmaxf(p0[r], p1[r]));
                mx = fmaxf(mx, __shfl_xor(mx, 32));
                const float m_new = fmaxf(m_run, mx), alpha = fast_exp2(m_run - m_new); m_run = m_new;
                float ps = 0.f;
#pragma unroll
                for (int r = 0; r < 16; ++r) { p0[r] = fast_exp2(p0[r] - m_new); p1[r] = fast_exp2(p1[r] - m_new); ps += p0[r] + p1[r]; }
                lsum = lsum * alpha + ps;
#pragma unroll
                for (int r = 0; r < 16; ++r) { o0[r] *= alpha; o1[r] *= alpha; }
                h16x8 pb[4];
#pragma unroll
                for (int e = 0; e < 8; ++e) { pb[0][e] = (h16)p0[e]; pb[1][e] = (h16)p0[8 + e]; pb[2][e] = (h16)p1[e]; pb[3][e] = (h16)p1[8 + e]; }
#pragma unroll
                for (int t = 0; t < 4; ++t) {
                    const h16x8 va = {vf[t][0][0], vf[t][0][1], vf[t][0][2], vf[t][0][3], vf[t][1][0], vf[t][1][1], vf[t][1][2], vf[t][1][3]};
                    const h16x8 vc2 = {vf[t][2][0], vf[t][2][1], vf[t][2][2], vf[t][2][3], vf[t][3][0], vf[t][3][1], vf[t][3][2], vf[t][3][3]};
                    o0 = __builtin_amdgcn_mfma_f32_32x32x16_f16(va, pb[t], o0, 0, 0, 0);
                    o1 = __builtin_amdgcn_mfma_f32_32x32x16_f16(vc2, pb[t], o1, 0, 0, 0);
                }
        };
        for (int J = 0; J < NT2; ++J) {
            const int buf = J & 1;
            if (J + 1 < NT2) LOADT(J + 1, rowbase, h);
            else if (has_next) LOADT(0, rowbase_n, h_n);
            if (2 * J <= my_last) compute(Kb + buf * 128 * KPITCH, Vb + buf * 64 * VPITCH);
            if (2 * J + 1 <= my_last) compute(Kb + buf * 128 * KPITCH + 64 * KPITCH, Vb + buf * 64 * VPITCH + 128);
            if (J + 1 == NT2 && has_next) LOADQ(qf, un);
            if (J + 1 < NT2 || has_next) STORET(buf ^ 1);
            LDS_BARRIER();
        }
        lsum += __shfl_xor(lsum, 32);
        const float inv = 1.f / lsum;
        LAS h16* sg = (LAS h16*)Sg;
#pragma unroll
        for (int r = 0; r < 16; ++r) { const int d = (r & 3) + 8 * (r >> 2) + 4 * hi; sg[r32 * 72 + d] = (h16)(o0[r] * inv); sg[r32 * 72 + 32 + d] = (h16)(o1[r] * inv); }
        asm volatile("s_waitcnt lgkmcnt(0)" ::: "memory");
#pragma unroll
        for (int i = 0; i < 4; ++i) { const int id = i * 64 + lane, row = id >> 3, c = id & 7;
            const u32x4 v = *(const LAS u32x4*)(Sg + row * 144 + c * 16);
            *(u32x4*)(YC + (rowbase + q0 + wid * 32 + row) * DM + h * 64 + c * 8) = v; }
        asm volatile("s_waitcnt lgkmcnt(0)" ::: "memory");
    }
#undef LOADT
#undef STORET
#undef LOADQ
}


#define XB_TMO      128
#define XB_XCNT(j)  (256  + 64 * (j))
#define XB_XSUB(j)  (1280 + 64 * (j))
#define XB_XGEN(j)  (2304 + 64 * (j))
#define XB_TOP      3328
#define XB_TOPGEN   3392
#define XCD_BAR_WORDS 3456
#define XB_SPIN_CAP (1u << 18)
__device__ __forceinline__ unsigned xb_ld(unsigned* p)              { return __hip_atomic_load(p, __ATOMIC_RELAXED, __HIP_MEMORY_SCOPE_AGENT); }
__device__ __forceinline__ unsigned xb_add(unsigned* p, unsigned v) { return __hip_atomic_fetch_add(p, v, __ATOMIC_RELAXED, __HIP_MEMORY_SCOPE_AGENT); }
__device__ __forceinline__ unsigned xb_xcc_id() { return (unsigned)__builtin_amdgcn_s_getreg((3 << 11) | 20) & 0xFu; }
#define XB_SPIN(cond, bar) do { unsigned _sp = 0; while (cond) { __builtin_amdgcn_s_sleep(1); \
    if ((++_sp & 255u) == 0u) { if (xb_ld(&(bar)[XB_TMO])) break; if (_sp > XB_SPIN_CAP) { atomicAdd(&(bar)[XB_TMO], 1u); break; } } } } while (0)
struct XcdBarrier { unsigned* bar; unsigned x; volatile LAS unsigned* st; };
__device__ __forceinline__ XcdBarrier xcd_barrier_post(unsigned* bar, volatile LAS unsigned* st) {
    XcdBarrier b; b.bar = bar; b.x = xb_xcc_id(); b.st = st;
    if (threadIdx.x == 0) (void)xb_add(&bar[XB_XCNT(b.x)], 1u);
    return b;
}
__device__ __forceinline__ void xcd_barrier_complete(unsigned* bar, unsigned x, unsigned& nloc, unsigned& nx) {
    const unsigned G = gridDim.x * gridDim.y * gridDim.z;
    unsigned sum, cnt, mine, sp = 0u;
    for (;;) {
        sum = 0u; cnt = 0u; mine = 0u;
#pragma unroll
        for (unsigned j = 0; j < 16; ++j) { const unsigned c = xb_ld(&bar[XB_XCNT(j)]); sum += c; cnt += (c > 0u) ? 1u : 0u; mine = (j == x) ? c : mine; }
        if (sum == G) break;
        __builtin_amdgcn_s_sleep(1);
        if ((++sp & 255u) == 0u) { if (xb_ld(&bar[XB_TMO])) break; if (sp > XB_SPIN_CAP) { atomicAdd(&bar[XB_TMO], 1u); break; } }
    }
    nloc = mine > 0u ? mine : 1u; nx = cnt > 0u ? cnt : 1u;
}
__device__ __forceinline__ void xcd_barrier(const XcdBarrier& b) {
    asm volatile("s_waitcnt vmcnt(0)" ::: "memory");
    __syncthreads();
    if (threadIdx.x == 0) {
        unsigned* bar = (unsigned*)(kparams()->ws + WS_BAR); asm volatile("" : "+v"(bar));
        __builtin_amdgcn_s_waitcnt(0);
        unsigned nloc = b.st[0], nx = b.st[1];
        if (nloc == 0u) { xcd_barrier_complete(bar, b.x, nloc, nx); b.st[0] = nloc; b.st[1] = nx; }
        const unsigned old = xb_add(&bar[XB_XSUB(b.x)], 1u);
        const unsigned gen = old / nloc;
        if (old + 1u == (gen + 1u) * nloc) {
            __builtin_amdgcn_fence(__ATOMIC_RELEASE, "agent");
            asm volatile("s_waitcnt vmcnt(0)" ::: "memory");
            const unsigned og = xb_add(&bar[XB_TOP], 1u);
            const unsigned tg = og / nx;
            if (og + 1u == (tg + 1u) * nx) xb_add(&bar[XB_TOPGEN], 1u);
            else XB_SPIN(xb_ld(&bar[XB_TOPGEN]) == tg, bar);
            __builtin_amdgcn_fence(__ATOMIC_ACQUIRE, "agent");
            xb_add(&bar[XB_XGEN(b.x)], 1u);
            asm volatile("s_waitcnt vmcnt(0)" ::: "memory");
        } else {
            XB_SPIN(xb_ld(&bar[XB_XGEN(b.x)]) == gen, bar);
            __builtin_amdgcn_fence(__ATOMIC_ACQUIRE, "agent");
            asm volatile("s_waitcnt vmcnt(0)" ::: "memory");
        }
    }
    __syncthreads();
}

struct GT { unsigned long long a, b, o; int lda, ldb, K, nM, nN, nZ1, nZ2, a_s1, a_s2, b_s1, b_s2, epi, ldc, rkind, bias, fold, st_in, st_out, cs, gidx, gl; float scale; int ph; };
__device__ const GT GTAB[] = {
    {WS_MEMH, WS_W + 0ull * 32 * MiB + WO_XWKV * 2, WS_XK, 1024, 1024, 1024, 32, 4, 1, 2, 0, 0, 0, 16777216, E_F16, 2048, 0, -1, 0, 0, 0, 0, 0, 0, 1.f, 1},
    {WS_W + 0ull * 32 * MiB + (WO_XWKV + 1024 * 1024) * 2, WS_MEMH, WS_XVT, 1024, 1024, 1024, 4, 32, 2, 1, 16777216, 0, 0, 0, E_F16, MEMT, 0, -1, 0, 0, 0, 0, 0, 0, 1.f, 1},
    {WS_XH, WS_W + 0ull * 32 * MiB + WO_WIN * 2, WS_PROJ, 1024, 1024, 1024, 256, 7, 1, 1, 0, 0, 0, 0, E_INPROJ, 0, 0, (int)WS_BIAS, 0, 0, 0, 0, 0, 0, 1.f, 1},
    {WS_PROJ, WS_W + 0ull * 32 * MiB + WO_WUQ * 2, WS_Q, PROJW, 256, 256, 256, 3, 1, 1, 0, 0, 0, 0, E_QUP, 0, 0, -1, 0, 0, 0, 0, 0, 0, 1.f, 3},
    {WS_PROJ + 512, WS_W + 0ull * 32 * MiB + WO_WUK * 2, WS_KN, PROJW, 256, 256, 256, 2, 1, 1, 0, 0, 0, 0, E_KUP, 0, 0, -1, 0, 0, 0, 0, 0, 0, 1.f, 3},
    {WS_W + 0ull * 32 * MiB + WO_WUV * 2, WS_PROJ + 512, WS_VT, 256, PROJW, 256, 2, 256, 1, 1, 0, 0, 0, 0, E_VTUP, 0, 0, -1, 0, 0, 0, 0, 0, 0, 1.f, 3},
    {WS_YCAT, WS_W + 0ull * 32 * MiB + WO_WO * 2, 0, 1024, 1024, 1024, 256, 4, 1, 1, 0, 0, 0, 0, E_RESID0, 0, 1, -1, 0, 0, 0, 0, 0, 0, 1.f, 5},
    {WS_XH, WS_W + 0ull * 32 * MiB + WO_XWQ * 2, WS_XQ, 1024, 1024, 1024, 256, 4, 1, 1, 0, 0, 0, 0, E_F16, 1024, 0, -1, 1, 0, 0, 0 * NCS + 1792, 0, 0, XQSCALE, 7},
    {WS_XQ, WS_XK + 0 * 2048, WS_P, 1024, 2048, 256, 8, 1, 32, 4, SEQ * 1024, 256, 256 * 2048, 256, E_SOFTMAX, 0, 0, -1, 0, 0, 0, 0, 0, 0, 1.f, 8},
    {WS_P, WS_XVT + 0ull * 16 * MiB, WS_XO, 1024, MEMT, 256, 8, 1, 32, 4, SEQ * 1024, 256, 256, 256 * MEMT, E_F16, 1024, 0, -1, 0, 0, 0, 0, 0, 0, 1.f, 9},
    {WS_XO, WS_W + 0ull * 32 * MiB + WO_XWO * 2, 0, 1024, 1024, 1024, 256, 4, 1, 1, 0, 0, 0, 0, E_RESID, 0, 2, -1, 1, 0, 1, 0, 14, 0, 1.f, 10},
    {WS_XH, WS_W + 0ull * 32 * MiB + WO_FWIN * 2, WS_H, 1024, 1024, 1024, 256, 22, 1, 1, 0, 0, 0, 0, E_SWIGLU, 0, 0, -1, 1, 1, 0, 0 * NCS + 2816, 0, 0, 1.f, 12},
    {WS_H, WS_W + 0ull * 32 * MiB + WO_FWD * 2, 0, FFH, FFH, FFH, 256, 4, 1, 1, 0, 0, 0, 0, E_RESID, 0, 2, -1, 1, 1, 0, 0, 19, 0, 1.f, 13},
    {WS_XH, WS_W + 1ull * 32 * MiB + WO_WIN * 2, WS_PROJ, 1024, 1024, 1024, 256, 7, 1, 1, 0, 0, 0, 0, E_INPROJ, 0, 0, (int)WS_BIAS + 1 * 1792 * 4, 1, 0, 0, 1 * NCS, 0, 0, 1.f, 15},
    {WS_PROJ, WS_W + 1ull * 32 * MiB + WO_WUQ * 2, WS_Q, PROJW, 256, 256, 256, 3, 1, 1, 0, 0, 0, 0, E_QUP, 0, 0, -1, 0, 0, 0, 0, 0, 0, 1.f, 16},
    {WS_PROJ + 512, WS_W + 1ull * 32 * MiB + WO_WUK * 2, WS_KN, PROJW, 256, 256, 256, 2, 1, 1, 0, 0, 0, 0, E_KUP, 0, 0, -1, 0, 0, 0, 0, 0, 0, 1.f, 16},
    {WS_W + 1ull * 32 * MiB + WO_WUV * 2, WS_PROJ + 512, WS_VT, 256, PROJW, 256, 2, 256, 1, 1, 0, 0, 0, 0, E_VTUP, 0, 0, -1, 0, 0, 0, 0, 0, 0, 1.f, 16},
    {WS_YCAT, WS_W + 1ull * 32 * MiB + WO_WO * 2, 0, 1024, 1024, 1024, 256, 4, 1, 1, 0, 0, 0, 0, E_RESID, 0, 2, -1, 1, 0, 1, 0, 23, 0, 1.f, 18},
    {WS_XH, WS_W + 1ull * 32 * MiB + WO_XWQ * 2, WS_XQ, 1024, 1024, 1024, 256, 4, 1, 1, 0, 0, 0, 0, E_F16, 1024, 0, -1, 1, 1, 0, 1 * NCS + 1792, 0, 0, XQSCALE, 20},
    {WS_XQ, WS_XK + 1 * 2048, WS_P, 1024, 2048, 256, 8, 1, 32, 4, SEQ * 1024, 256, 256 * 2048, 256, E_SOFTMAX, 0, 0, -1, 0, 0, 0, 0, 0, 0, 1.f, 21},
    {WS_P, WS_XVT + 1ull * 16 * MiB, WS_XO, 1024, MEMT, 256, 8, 1, 32, 4, SEQ * 1024, 256, 256, 256 * MEMT, E_F16, 1024, 0, -1, 0, 0, 0, 0, 0, 0, 1.f, 22},
    {WS_XO, WS_W + 1ull * 32 * MiB + WO_XWO * 2, 0, 1024, 1024, 1024, 256, 4, 1, 1, 0, 0, 0, 0, E_RESID, 0, 2, -1, 1, 1, 0, 0, 14, 1, 1.f, 23},
    {WS_XH, WS_W + 1ull * 32 * MiB + WO_FWIN * 2, WS_H, 1024, 1024, 1024, 256, 22, 1, 1, 0, 0, 0, 0, E_SWIGLU, 0, 0, -1, 1, 0, 0, 1 * NCS + 2816, 0, 0, 1.f, 25},
    {WS_H, WS_W + 1ull * 32 * MiB + WO_FWD * 2, 0, FFH, FFH, FFH, 256, 4, 1, 1, 0, 0, 0, 0, E_RESID, 0, 2, -1, 1, 0, 1, 0, 19, 1, 1.f, 26},
    {0, 0, 0, 0, 0, 0, 0, 0, 0, 0, 0, 0, 0, 0, 0, 0, 0, 0, 0, 0, 0, 0, 0, 0, 0.f, 99},
};
__device__ __forceinline__ void load_gemm(GemmDesc& g, int ti, KP P) {
    const GT& t = GTAB[ti]; unsigned char* ws = P->ws;
    g.A = (const h16*)(ws + t.a); g.B = (const h16*)(ws + t.b); g.lda = t.lda; g.ldb = t.ldb; g.K = t.K; g.nM = t.nM; g.nN = t.nN; g.nZ1 = t.nZ1; g.nZ2 = t.nZ2;
    g.a_s1 = t.a_s1; g.a_s2 = t.a_s2; g.b_s1 = t.b_s1; g.b_s2 = t.b_s2; g.epi = t.epi; g.ldc = t.ldc; g.scale = t.scale; g.fold = t.fold;
    g.out = (void*)(ws + ((t.epi == E_RESID || t.epi == E_RESID0) ? WS_XH : t.o));
    g.st_in = (const float*)(ws + WS_ST) + (size_t)t.st_in * TT * 8; g.st_out = (float*)(ws + WS_ST) + (size_t)t.st_out * TT * 8;
    g.cs = (const float*)(ws + WS_CSBW) + t.cs;
    if (t.rkind == 1) { g.res = P->in[0]; g.bias = nullptr; }
    else if (t.rkind == 2) { g.res = P->in[t.gidx] + t.gl * DM; g.bias = P->in[t.gidx + 1] + t.gl * DM; }
    else { g.res = nullptr; g.bias = (const float*)(ws + (t.bias < 0 ? 0 : t.bias)); }
}

__global__ void __launch_bounds__(512, 2) fwd_megakernel(Params Pval) {
    extern __shared__ __attribute__((aligned(16))) unsigned char lds_raw[];
    LAS unsigned char* lds = (LAS unsigned char*)lds_raw;
    cg::grid_group grid = cg::this_grid();
    volatile LAS unsigned* bst = (volatile LAS unsigned*)(lds + 131072 + 8192 + 1024);
    if (threadIdx.x < 2) bst[threadIdx.x] = 0u;
    XcdBarrier xbar; xbar.bar = nullptr; xbar.x = 0; xbar.st = bst;
    int ti = 0;
    {
        KP P = kparams();
        if (bid_here() == 0) { unsigned* bw = (unsigned*)(P->ws + WS_BAR); for (int i = tid_here(); i < XCD_BAR_WORDS; i += 512) bw[i] = 0u; }
        prologue(lds, P);
        grid.sync();
        xbar = xcd_barrier_post((unsigned*)(P->ws + WS_BAR), bst);
    }
    for (int ph = 1; ph < 28; ++ph) {
        { const int sq = ph < 2 ? -1 : (ph - 2) % 13; if (ph == 2 || sq == 4 || sq == 9 || (sq == 12 && ph != 27)) continue; }
        KP P = kparams();
        {
            const int l = ph < 2 ? 0 : (ph - 2) / 13, s = ph < 2 ? -1 : (ph - 2) % 13;
            if (s == 1) conv_phase(lds, P, l);
            if (s == 2) attn_phase(lds, P);
            if (ph == 1) csbw_finalize(P);
            if (s == 12 && l == 1) ln_final(P, P->in[23] + DM, P->in[24] + DM);
            for (; GTAB[ti].ph == ph; ++ti) {
              {
                GemmDesc g; load_gemm(g, ti, P);
                unsigned char* ws = P->ws;
                __syncthreads();
                switch (g.epi) {
                case E_INPROJ: gemm_run<E_INPROJ>(lds, g, ws); break;
                case E_QUP: gemm_run<E_QUP>(lds, g, ws); break;
                case E_KUP: gemm_run<E_KUP>(lds, g, ws); break;
                case E_VTUP: gemm_run<E_VTUP>(lds, g, ws); break;
                case E_F16: gemm_run<E_F16>(lds, g, ws); break;
                case E_RESID: gemm_run<E_RESID>(lds, g, ws); break;
                case E_RESID0: gemm_run<E_RESID0>(lds, g, ws); break;
                case E_SOFTMAX: gemm_run<E_SOFTMAX>(lds, g, ws); break;
                default: gemm_run<E_SWIGLU>(lds, g, ws); break;
                }
                __syncthreads();
              }
            }
        }
        if (ph != 27) xcd_barrier(xbar);
    }
}

extern "C" void kernel_launch(void* const* d_in, const int* in_sizes, int n_in, void* d_out, int out_size, void* d_ws, size_t ws_size, hipStream_t stream) {
    static int grid_blocks = 0;
    if (!grid_blocks) {
        if (n_in != 25 || ws_size < WS_END) { fprintf(stderr, "kernel_launch: unexpected n_in %d / ws_size %zu\n", n_in, ws_size); grid_blocks = -1; return; }
        int dev = 0, cus = 0, per_cu = 0;
        hipGetDevice(&dev);
        hipDeviceGetAttribute(&cus, hipDeviceAttributeMultiprocessorCount, dev);
        if (hipFuncSetAttribute((const void*)fwd_megakernel, hipFuncAttributeMaxDynamicSharedMemorySize, LDS_BYTES) != hipSuccess) fprintf(stderr, "kernel_launch: hipFuncSetAttribute failed\n");
        hipOccupancyMaxActiveBlocksPerMultiprocessor(&per_cu, (const void*)fwd_megakernel, 512, LDS_BYTES);
        if (per_cu < 1) { fprintf(stderr, "kernel_launch: occupancy query gave %d\n", per_cu); per_cu = 1; }
        grid_blocks = cus * 1;
        (void)hipGetLastError();
    }
    if (grid_blocks < 0) return;
    Params p{};
    for (int i = 0; i < 25; ++i) p.in[i] = (const float*)d_in[i];
    p.pos = (const int*)d_in[2];
    p.out = (float*)d_out; p.ws = (unsigned char*)d_ws;
    void* args[] = {&p};
    hipError_t e = hipLaunchCooperativeKernel((const void*)fwd_megakernel, dim3(grid_blocks), dim3(512), args, LDS_BYTES, stream);
    if (e != hipSuccess) fprintf(stderr, "cooperative launch failed: %s (grid %d)\n", hipGetErrorString(e), grid_blocks);
}
```

```cpp
#include <hip/hip_runtime.h>
#include <hip/hip_cooperative_groups.h>
#include <cstdio>
#include <cstdint>
namespace cg = cooperative_groups;

#define LAS __attribute__((address_space(3)))
typedef _Float16 h16;
typedef _Float16 h16x8 __attribute__((ext_vector_type(8)));
typedef _Float16 h16x4 __attribute__((ext_vector_type(4)));
typedef _Float16 h16x2 __attribute__((ext_vector_type(2)));
typedef float f32x4 __attribute__((ext_vector_type(4)));
typedef float f32x2 __attribute__((ext_vector_type(2)));
typedef float f32x16 __attribute__((ext_vector_type(16)));
typedef unsigned u32x4 __attribute__((ext_vector_type(4)));

constexpr int TT = 65536, DM = 1024, SEQ = 2048, NB = 32, MEMT = 8192, FFH = 2816;
constexpr int PROJW = 1536;
constexpr float ALPHA = 1.4142135623730951f;
constexpr float QSCALE = 0.14724444602590306f;
constexpr float XQSCALE = 0.09016844005556021f;
constexpr size_t MiB = 1u << 20;
constexpr size_t WS_BIAS = 0;
constexpr size_t WS_W = 1 * MiB;
constexpr size_t WS_COS = 65 * MiB, WS_SIN = 69 * MiB, WS_SSQ = 73 * MiB;
constexpr size_t WS_MEMH = 76 * MiB, WS_XK = 92 * MiB, WS_XVT = 124 * MiB;
constexpr size_t WS_XH = 156 * MiB, WS_YCAT = 284 * MiB, WS_VT = 412 * MiB, WS_KR = 476 * MiB, WS_BIG = 480 * MiB;
constexpr size_t WS_PROJ = WS_BIG, WS_Q = WS_BIG + 224 * MiB, WS_KN = WS_BIG + 320 * MiB;
constexpr size_t WS_XQ = WS_BIG, WS_P = WS_BIG + 128 * MiB, WS_XO = WS_BIG + 256 * MiB, WS_H = WS_BIG;
constexpr size_t WS_PART = 864 * MiB;
constexpr size_t WS_CSBW = 867 * MiB;
constexpr size_t WS_ST = 868 * MiB;
constexpr size_t WS_END = 872 * MiB;
constexpr int NCS = 1792 + 1024 + 5632;
constexpr size_t WO_WIN = 0, WO_WUQ = WO_WIN + 1792 * 1024, WO_WUK = WO_WUQ + 768 * 256, WO_WUV = WO_WUK + 512 * 256,
                 WO_WO = WO_WUV + 512 * 256, WO_XWQ = WO_WO + 1024 * 1024, WO_XWKV = WO_XWQ + 1024 * 1024,
                 WO_XWO = WO_XWKV + 2048 * 1024, WO_FWIN = WO_XWO + 1024 * 1024, WO_FWD = WO_FWIN + 5632 * 1024,
                 WO_END = WO_FWD + 1024 * 2816;
static_assert(WO_END * 2 <= 32 * MiB, "weights per layer");
constexpr int LDS_STATS = 131072 + 8192 + 1024 + 64;
constexpr int LDS_COLS = LDS_STATS + 2 * 8192;
constexpr int LDS_BYTES = LDS_COLS + 2 * 2048;
constexpr size_t WS_BAR = 256 * 1024;

struct Params {
    const float* in[25];
    const int* pos;
    float* out;
    unsigned char* ws;
};

typedef const __attribute__((address_space(4))) Params* KP;
__device__ __forceinline__ KP kparams() { KP p = (KP)__builtin_amdgcn_kernarg_segment_ptr(); asm volatile("" : "+s"(p)); return p; }

__device__ __forceinline__ int tid_here() { int t = threadIdx.x; asm volatile("" : "+v"(t)); return t; }
__device__ __forceinline__ int bid_here() { int b = blockIdx.x; asm volatile("" : "+s"(b)); return b; }

__device__ __forceinline__ float wave_sum(float v) {
#pragma unroll
    for (int o = 1; o < 64; o <<= 1) v += __shfl_xor(v, o);
    return v;
}
__device__ __forceinline__ h16x4 cvt4(f32x4 v) { h16x4 r; r[0] = (h16)v[0]; r[1] = (h16)v[1]; r[2] = (h16)v[2]; r[3] = (h16)v[3]; return r; }
__device__ __forceinline__ float fast_exp2(float x) { return __builtin_amdgcn_exp2f(x); }

constexpr int BM = 256, BK = 64, HALF = 128, HTB = HALF * BK * 2, NXCD = 8, WGM = 8;
__device__ __forceinline__ int lds_byte(int r, int c) { const int st = (r >> 4) * 2 + (c >> 5), rr = r & 15, cc = c & 31, ob = rr * 64 + cc * 2; return st * 1024 + (ob ^ (((ob >> 9) & 1) << 5)); }
__device__ __forceinline__ void stage_rc(int b, int& R, int& C) { const int st = b / 1024, sb = b % 1024, swz = sb ^ (((sb >> 9) & 1) << 5); R = (st >> 1) * 16 + swz / 64; C = (st & 1) * 32 + (swz % 64) / 2; }

__device__ __forceinline__ int perm32(int rho) { const int n = rho >> 4, i = rho & 15; return 8 * (i >> 2) + 4 * n + (i & 3); }
enum { E_INPROJ = 0, E_QUP, E_KUP, E_VTUP, E_F16, E_RESID, E_SOFTMAX, E_SWIGLU, E_RESID0 };
struct GemmDesc {
    const h16* A; const h16* B; int lda, ldb, K;
    int nM, nN, nZ1, nZ2;
    int a_s1, a_s2, b_s1, b_s2;
    int epi;
    void* out; int ldc; float scale; const float* res; const float* bias;
    const float* st_in; float* st_out; const float* cs; int fold;
};
struct Unit { int row0, col0, pn; unsigned a, b; };

__device__ __forceinline__ bool unit_next(const GemmDesc& g, int i, int G, int c, Unit& u) {
    const int nwg = g.nZ1 * g.nZ2 * g.nM * g.nN;
    const long L = (long)i * G + c; if (L >= nwg) return false;
    int zb = 0, zh = 0, pm, pn;
    if (g.nZ1 * g.nZ2 == 1) {
        const int nM = g.nM, nN = g.nN;
        int wgid = (int)L; { const int q = nwg / NXCD, r = nwg % NXCD, xcd = wgid % NXCD, off = wgid / NXCD; wgid = (xcd < r ? xcd * (q + 1) : r * (q + 1) + (xcd - r) * q) + off; }
        const int nig = WGM * nN, gid = wgid / nig, fm = gid * WGM, gsz = (nM - fm) < WGM ? (nM - fm) : WGM;
        pm = fm + ((wgid % nig) % gsz); pn = (wgid % nig) / gsz;
    } else {
        int r = (int)L; pn = r % g.nN; r /= g.nN; pm = r % g.nM; r /= g.nM; zh = r % g.nZ2; zb = r / g.nZ2;
    }
    u.row0 = (zb * g.nM + pm) * BM; u.col0 = (zh * g.nN + pn) * BM; u.pn = pn;
    u.a = (unsigned)(zb * g.a_s1 + zh * g.a_s2 + pm * BM * g.lda) * 2u;
    u.b = (unsigned)(zb * g.b_s1 + zh * g.b_s2 + pn * BM * g.ldb) * 2u;
    return true;
}

__device__ __forceinline__ void row_stats(const LAS float* st, int row, float& mu, float& rstd) {
    const f32x4 a = *(const LAS f32x4*)(st + row * 8), b = *(const LAS f32x4*)(st + row * 8 + 4);
    mu = ((a[0] + a[2]) + (b[0] + b[2])) * (1.f / DM);
    const float var = ((a[1] + a[3]) + (b[1] + b[3])) * (1.f / DM) - mu * mu;
    rstd = __builtin_amdgcn_rsqf(var + 1e-5f);
}
template <int CN> __device__ __forceinline__ void fold_acc(f32x4 (&acc)[2][2][4][2], const LAS float* stl, const LAS float* ctl, int rloc, int cloc) {
    f32x4 cs[2][2], bw[2][2];
#pragma unroll
    for (int bj = 0; bj < 2; ++bj)
#pragma unroll
        for (int n = 0; n < 2; ++n) { cs[bj][n] = *(const LAS f32x4*)(ctl + cloc + bj * HALF + n * CN); bw[bj][n] = *(const LAS f32x4*)(ctl + 256 + cloc + bj * HALF + n * CN); }
#pragma unroll
    for (int ai = 0; ai < 2; ++ai)
#pragma unroll
        for (int m = 0; m < 4; ++m) { float mu, rstd; row_stats(stl, rloc + ai * HALF + m * 16, mu, rstd);
#pragma unroll
            for (int bj = 0; bj < 2; ++bj)
#pragma unroll
                for (int n = 0; n < 2; ++n) acc[ai][bj][m][n] = (acc[ai][bj][m][n] - cs[bj][n] * mu) * rstd + bw[bj][n]; }
}

#define LDS_BARRIER() asm volatile("s_waitcnt lgkmcnt(0)\n\ts_barrier" ::: "memory")
template <int EPI> __device__ __forceinline__ void epilogue(const GemmDesc& g, const Unit& u, f32x4 (&acc)[2][2][4][2], int wr, int wc, int fr, int fq,
                                         LAS unsigned char* lds, unsigned char* ws, const LAS float* stl, const LAS float* ctl) {
    const float* COS = (const float*)(ws + WS_COS); const float* SIN = (const float*)(ws + WS_SIN); float* SSQ = (float*)(ws + WS_SSQ);
    const int rbase = u.row0 + wr * 64 + fr;
    constexpr int CN = 4;
    const int cbase = u.col0 + wc * 32 + 8 * fq;
    if (EPI == E_INPROJ || EPI == E_F16 || EPI == E_SWIGLU) { if (g.fold) fold_acc<CN>(acc, stl, ctl, wr * 64 + fr, cbase - u.col0); }
    switch (EPI) {
    case E_INPROJ: {
        if (u.pn < 6) {
            h16* O = (h16*)g.out;
            f32x4 bv[2][2];
#pragma unroll
            for (int bj = 0; bj < 2; ++bj)
#pragma unroll
                for (int n = 0; n < 2; ++n) bv[bj][n] = *(const f32x4*)(g.bias + cbase + bj * HALF + n * CN);
#pragma unroll
            for (int ai = 0; ai < 2; ++ai)
#pragma unroll
                for (int m = 0; m < 4; ++m) {
                    const int row = rbase + ai * HALF + m * 16; float ss = 0.f;
#pragma unroll
                    for (int bj = 0; bj < 2; ++bj)
#pragma unroll
                        for (int n = 0; n < 2; ++n) { const f32x4 v = acc[ai][bj][m][n] + bv[bj][n]; ss += (v[0] * v[0] + v[1] * v[1]) + (v[2] * v[2] + v[3] * v[3]);
                            *(h16x4*)(O + (size_t)row * PROJW + cbase + bj * HALF + n * CN) = cvt4(v); }
                    if (u.pn < 2) { ss += __shfl_xor(ss, 16); ss += __shfl_xor(ss, 32); if (fq == 0) SSQ[(size_t)row * 8 + u.pn * 4 + wc] = ss; }
                }
        } else if (wc == 0) {
            h16* KR = (h16*)(ws + WS_KR);
            const f32x4 b0 = *(const f32x4*)(g.bias + 1536 + 4 * fq), b1 = *(const f32x4*)(g.bias + 1536 + 16 + 4 * fq);
#pragma unroll
            for (int ai = 0; ai < 2; ++ai)
#pragma unroll
                for (int m = 0; m < 4; ++m) {
                    const int row = rbase + ai * HALF + m * 16;
                    const f32x4 c = *(const f32x4*)(COS + (size_t)row * 16 + 4 * fq), s = *(const f32x4*)(SIN + (size_t)row * 16 + 4 * fq);
                    const f32x4 v0 = acc[ai][0][m][0] + b0, v1 = acc[ai][0][m][1] + b1;
                    *(h16x4*)(KR + (size_t)row * 32 + 4 * fq) = cvt4(v0 * c - v1 * s);
                    *(h16x4*)(KR + (size_t)row * 32 + 16 + 4 * fq) = cvt4(v0 * s + v1 * c);
                }
        }
    } break;
    case E_QUP: {
        h16* O = (h16*)g.out;
#pragma unroll
        for (int ai = 0; ai < 2; ++ai) {
            float scr_[4]; f32x4 cr[4], sr[4];
#pragma unroll
            for (int m = 0; m < 4; ++m) { const int row = rbase + ai * HALF + m * 16;
                const f32x4 q4 = *(const LAS f32x4*)(stl + (row - u.row0) * 8);
                scr_[m] = QSCALE * __builtin_amdgcn_rsqf(((q4[0] + q4[1]) + (q4[2] + q4[3])) * (1.f / 256.f) + 1e-6f);
                cr[m] = *(const f32x4*)(COS + (size_t)row * 16 + 4 * fq); sr[m] = *(const f32x4*)(SIN + (size_t)row * 16 + 4 * fq); }
#pragma unroll
            for (int m = 0; m < 4; ++m) {
                const int row = rbase + ai * HALF + m * 16;
                const float sc = scr_[m]; const f32x4 c = cr[m], s = sr[m];
#pragma unroll
                for (int bj = 0; bj < 2; ++bj) {
                    const int gcol = u.col0 + bj * HALF + wc * 32;
                    const f32x4 v0 = acc[ai][bj][m][0] * sc, v1 = acc[ai][bj][m][1] * sc;
                    if ((gcol >> 5) % 3 == 2) {
                        *(h16x4*)(O + (size_t)row * 768 + gcol + 4 * fq) = cvt4(v0 * c - v1 * s);
                        *(h16x4*)(O + (size_t)row * 768 + gcol + 16 + 4 * fq) = cvt4(v0 * s + v1 * c);
                    } else {
                        *(h16x4*)(O + (size_t)row * 768 + gcol + 8 * fq) = cvt4(v0);
                        *(h16x4*)(O + (size_t)row * 768 + gcol + 8 * fq + 4) = cvt4(v1);
                    }
                }
            }
        }
    } break;
    case E_KUP: {
        h16* O = (h16*)g.out;
        float scr_[2][4];
#pragma unroll
        for (int ai = 0; ai < 2; ++ai)
#pragma unroll
            for (int m = 0; m < 4; ++m) { const f32x4 q4 = *(const LAS f32x4*)(stl + (rbase - u.row0 + ai * HALF + m * 16) * 8 + 4);
                scr_[ai][m] = __builtin_amdgcn_rsqf(((q4[0] + q4[1]) + (q4[2] + q4[3])) * (1.f / 256.f) + 1e-6f); }
#pragma unroll
        for (int ai = 0; ai < 2; ++ai)
#pragma unroll
            for (int m = 0; m < 4; ++m) {
                const int row = rbase + ai * HALF + m * 16; const float sc = scr_[ai][m];
#pragma unroll
                for (int bj = 0; bj < 2; ++bj)
#pragma unroll
                    for (int n = 0; n < 2; ++n) *(h16x4*)(O + (size_t)row * 512 + cbase + bj * HALF + n * CN) = cvt4(acc[ai][bj][m][n] * sc);
            }
    } break;
    case E_VTUP: {
        h16* O = (h16*)g.out;
        f32x4 sc[2][2];
#pragma unroll
        for (int bj = 0; bj < 2; ++bj)
#pragma unroll
            for (int n = 0; n < 2; ++n)
#pragma unroll
                for (int j = 0; j < 4; ++j) { const f32x4 q4 = *(const LAS f32x4*)(stl + (cbase - u.col0 + bj * HALF + n * CN + j) * 8 + 4);
                    sc[bj][n][j] = __builtin_amdgcn_rsqf(((q4[0] + q4[1]) + (q4[2] + q4[3])) * (1.f / 256.f) + 1e-6f); }
#pragma unroll
        for (int ai = 0; ai < 2; ++ai)
#pragma unroll
            for (int m = 0; m < 4; ++m) {
                const int row = rbase + ai * HALF + m * 16;
#pragma unroll
                for (int bj = 0; bj < 2; ++bj)
#pragma unroll
                    for (int n = 0; n < 2; ++n) *(h16x4*)(O + (size_t)row * TT + cbase + bj * HALF + n * CN) = cvt4(acc[ai][bj][m][n] * sc[bj][n]);
            }
    } break;
    case E_F16: {
        h16* O = (h16*)g.out; const float sc = g.scale; const int ldc = g.ldc;
#pragma unroll
        for (int ai = 0; ai < 2; ++ai)
#pragma unroll
            for (int m = 0; m < 4; ++m) {
                const int row = rbase + ai * HALF + m * 16;
#pragma unroll
                for (int bj = 0; bj < 2; ++bj)
#pragma unroll
                    for (int n = 0; n < 2; ++n) *(h16x4*)(O + (size_t)row * ldc + cbase + bj * HALF + n * CN) = cvt4(acc[ai][bj][m][n] * sc);
            }
    } break;
    case E_RESID0:
    case E_RESID: {
        constexpr bool FOLD = (EPI == E_RESID);
        const h16* ZH = (const h16*)(ws + WS_XH); h16* ZO = (h16*)g.out;
        LAS f32x2* PP = (LAS f32x2*)(lds + 131072);
#define RS_LOAD(ZB, XB, ai_, m0_) do { _Pragma("unroll") for (int mm = 0; mm < 2; ++mm) { const size_t off_ = (size_t)(rbase + (ai_) * HALF + ((m0_) + mm) * 16) * DM + cbase; \
            _Pragma("unroll") for (int bj = 0; bj < 2; ++bj) { if (FOLD) ZB[mm][bj] = *(const h16x8*)(ZH + off_ + bj * HALF); \
                else { XB[mm][bj][0] = *(const f32x4*)(g.res + off_ + bj * HALF); XB[mm][bj][1] = *(const f32x4*)(g.res + off_ + bj * HALF + 4); } } } } while (0)
#define RS_PROC(ZB, XB, ai_, m0_) do { _Pragma("unroll") for (int mm = 0; mm < 2; ++mm) { const int m = (m0_) + mm; \
            const int row = rbase + (ai_) * HALF + m * 16; const size_t off = (size_t)row * DM + cbase; \
            float mu_ = 0.f, rstd_ = 1.f; if (FOLD) row_stats(stl, row - u.row0, mu_, rstd_); \
            const LAS float* ctr = ctl + (cbase - u.col0); asm volatile("" : "+v"(ctr)); \
            float ps = 0.f, pss = 0.f; \
            _Pragma("unroll") for (int bj = 0; bj < 2; ++bj) { h16x8 zo; \
                _Pragma("unroll") for (int n = 0; n < 2; ++n) { f32x4 x; \
                    if (FOLD) { const f32x4 gvv = *(const LAS f32x4*)(ctr + bj * HALF + n * CN), bvv = *(const LAS f32x4*)(ctr + 256 + bj * HALF + n * CN); \
                        _Pragma("unroll") for (int j = 0; j < 4; ++j) x[j] = ((float)ZB[mm][bj][4 * n + j] - mu_) * rstd_ * gvv[j] + bvv[j]; } \
                    else x = XB[mm][bj][n]; \
                    const f32x4 z = x * ALPHA + acc[ai_][bj][m][n]; \
                    ps += (z[0] + z[1]) + (z[2] + z[3]); pss += (z[0] * z[0] + z[1] * z[1]) + (z[2] * z[2] + z[3] * z[3]); \
                    _Pragma("unroll") for (int j = 0; j < 4; ++j) zo[4 * n + j] = (h16)z[j]; } \
                *(h16x8*)(ZO + off + bj * HALF) = zo; } \
            ps += __shfl_xor(ps, 16); ps += __shfl_xor(ps, 32); pss += __shfl_xor(pss, 16); pss += __shfl_xor(pss, 32); \
            if (fq == 0) PP[((ai_) * HALF + wr * 64 + m * 16 + fr) * 4 + wc] = (f32x2){ps, pss}; } } while (0)
        if (FOLD) {
            h16x8 zA[2][2], zB[2][2]; f32x4 xd[2][2][2];
            RS_LOAD(zA, xd, 0, 0); RS_LOAD(zB, xd, 0, 2);
            RS_PROC(zA, xd, 0, 0); RS_LOAD(zA, xd, 1, 0);
            RS_PROC(zB, xd, 0, 2); RS_LOAD(zB, xd, 1, 2);
            RS_PROC(zA, xd, 1, 0);
            RS_PROC(zB, xd, 1, 2);
        } else {
            h16x8 zd[2][2]; f32x4 xA[2][2][2];
#pragma unroll
            for (int ai = 0; ai < 2; ++ai)
#pragma unroll
                for (int m0 = 0; m0 < 4; m0 += 2) { RS_LOAD(zd, xA, ai, m0); RS_PROC(zd, xA, ai, m0); }
        }
#undef RS_LOAD
#undef RS_PROC
        LDS_BARRIER();
        { const int t = wr * 256 + wc * 64 + fq * 16 + fr;
          if (t < 256) { const f32x2 a = PP[t * 4 + 0], b = PP[t * 4 + 1], c = PP[t * 4 + 2], d = PP[t * 4 + 3];
              *(f32x2*)(g.st_out + (size_t)(u.row0 + t) * 8 + u.pn * 2) = (f32x2){(a[0] + b[0]) + (c[0] + d[0]), (a[1] + b[1]) + (c[1] + d[1])}; } }
    } break;
    case E_SOFTMAX: {
        h16* O = (h16*)g.out;
        LAS float* PM = (LAS float*)(lds + 131072);
        LAS float* PS = (LAS float*)(lds + 131072 + 4096);
        float mx[2][4];
#pragma unroll
        for (int ai = 0; ai < 2; ++ai)
#pragma unroll
            for (int m = 0; m < 4; ++m) {
                float v = -INFINITY;
#pragma unroll
                for (int bj = 0; bj < 2; ++bj)
#pragma unroll
                    for (int n = 0; n < 2; ++n) { const f32x4 x = acc[ai][bj][m][n]; v = fmaxf(v, fmaxf(fmaxf(x[0], x[1]), fmaxf(x[2], x[3]))); }
                v = fmaxf(v, __shfl_xor(v, 16)); v = fmaxf(v, __shfl_xor(v, 32));
                if (fq == 0) PM[(ai * HALF + wr * 64 + m * 16 + fr) * 4 + wc] = v;
            }
        LDS_BARRIER();
#pragma unroll
        for (int ai = 0; ai < 2; ++ai)
#pragma unroll
            for (int m = 0; m < 4; ++m) {
                const f32x4 p = *(const LAS f32x4*)(PM + (ai * HALF + wr * 64 + m * 16 + fr) * 4);
                const float mm = fmaxf(fmaxf(p[0], p[1]), fmaxf(p[2], p[3])); mx[ai][m] = mm; float s = 0.f;
#pragma unroll
                for (int bj = 0; bj < 2; ++bj)
#pragma unroll
                    for (int n = 0; n < 2; ++n) { f32x4 x = acc[ai][bj][m][n];
#pragma unroll
                        for (int j = 0; j < 4; ++j) { x[j] = fast_exp2(x[j] - mm); s += x[j]; }
                        acc[ai][bj][m][n] = x; }
                s += __shfl_xor(s, 16); s += __shfl_xor(s, 32);
                if (fq == 0) PS[(ai * HALF + wr * 64 + m * 16 + fr) * 4 + wc] = s;
            }
        LDS_BARRIER();
#pragma unroll
        for (int ai = 0; ai < 2; ++ai)
#pragma unroll
            for (int m = 0; m < 4; ++m) {
                const f32x4 p = *(const LAS f32x4*)(PS + (ai * HALF + wr * 64 + m * 16 + fr) * 4);
                const float inv = 1.f / ((p[0] + p[1]) + (p[2] + p[3]));
                const int row = rbase + ai * HALF + m * 16;
#pragma unroll
                for (int bj = 0; bj < 2; ++bj)
#pragma unroll
                    for (int n = 0; n < 2; ++n) *(h16x4*)(O + (size_t)row * DM + cbase + bj * HALF + n * CN) = cvt4(acc[ai][bj][m][n] * inv);
            }
        (void)mx;
    } break;
    case E_SWIGLU: {
        h16* O = (h16*)g.out;
#pragma unroll
        for (int ai = 0; ai < 2; ++ai)
#pragma unroll
            for (int m = 0; m < 4; ++m) {
                const int row = rbase + ai * HALF + m * 16;
#pragma unroll
                for (int n = 0; n < 2; ++n) { const f32x4 gt = acc[ai][0][m][n], up = acc[ai][1][m][n]; f32x4 hv;
#pragma unroll
                    for (int j = 0; j < 4; ++j) hv[j] = gt[j] * __builtin_amdgcn_rcpf(1.f + fast_exp2(gt[j] * -1.4426950408889634f)) * up[j];
                    *(h16x4*)(O + (size_t)row * FFH + u.pn * HALF + (cbase - u.col0) + n * CN) = cvt4(hv); }
            }
    } break;
    default: break;
    }
}

template <int EPI> __device__ __forceinline__ void gemm_run(LAS unsigned char* lds, const GemmDesc& g, unsigned char* ws) {
    const int tid = tid_here(), wid = __builtin_amdgcn_readfirstlane(tid >> 6), lane = tid & 63, wr = wid >> 2, wc = wid & 3, fr = lane & 15, fq = lane >> 4;
    LAS int* utab = (LAS int*)(lds + 131072 + 8192);
    if (tid < 32) { Unit u; const bool ok = unit_next(g, tid, gridDim.x, bid_here(), u);
        utab[tid * 8 + 0] = ok ? u.row0 : -1; utab[tid * 8 + 1] = u.col0; utab[tid * 8 + 2] = u.pn; utab[tid * 8 + 3] = (int)u.a; utab[tid * 8 + 4] = (int)u.b; }
    __syncthreads();
#define UT(i, f) __builtin_amdgcn_readfirstlane(utab[(i) * 8 + (f)])
    const int nt = g.K / BK;
    const char* const gA = (const char*)g.A; const char* const gB = (const char*)g.B;
    unsigned voffA[2], voffB[2];
#pragma unroll
    for (int i = 0; i < 2; ++i) { int R, C; stage_rc(tid * 16 + i * 8192, R, C); const int Rb = (R & ~31) + perm32(R & 31);
        voffA[i] = (unsigned)(R * g.lda + C) * 2u; voffB[i] = (unsigned)(Rb * g.ldb + C) * 2u; }
    const unsigned kstep = (unsigned)(BK * 2);
    const unsigned hstepA = (unsigned)HALF * g.lda * 2u, hstepB = (unsigned)HALF * g.ldb * 2u;
    const unsigned ldsw = (unsigned)wid * 1024u;
    const int aoff = lds_byte(wr * 64 + fr, fq * 8), boff = lds_byte(wc * 32 + fr, fq * 8);
#define SA(b, h) (((b) * 2 + (h)) * HTB)
#define SB(b, h) ((4 + (b) * 2 + (h)) * HTB)
#define STAGE(bufoff, gbase, soff, voff) do { _Pragma("unroll") for (int _i = 0; _i < 2; ++_i) \
        __builtin_amdgcn_global_load_lds((const unsigned*)((gbase) + (size_t)((soff) + (voff)[_i])), (LAS unsigned*)(lds + (bufoff) + ldsw + _i * 8192), 16, 0, 0); } while (0)
#define LDA(dst, b, h) do { _Pragma("unroll") for (int m = 0; m < 4; ++m) _Pragma("unroll") for (int k = 0; k < 2; ++k) dst[m][k] = *(const LAS h16x8*)(lds + SA(b, h) + aoff + m * 2048 + k * 1024); } while (0)
#define LDB(dst, b, h) do { _Pragma("unroll") for (int n = 0; n < 2; ++n) _Pragma("unroll") for (int k = 0; k < 2; ++k) dst[n][k] = *(const LAS h16x8*)(lds + SB(b, h) + boff + n * 2048 + k * 1024); } while (0)
#define MMA(ai, bj, At, Bt) do { __builtin_amdgcn_s_setprio(1); _Pragma("unroll") for (int m = 0; m < 4; ++m) _Pragma("unroll") for (int n = 0; n < 2; ++n) _Pragma("unroll") for (int k = 0; k < 2; ++k) \
        acc[ai][bj][m][n] = __builtin_amdgcn_mfma_f32_16x16x32_f16(Bt[n][k], At[m][k], acc[ai][bj][m][n], 0, 0, 0); __builtin_amdgcn_s_setprio(0); } while (0)
#define MMAZ(ai, bj, At, Bt) do { __builtin_amdgcn_s_setprio(1); _Pragma("unroll") for (int m = 0; m < 4; ++m) _Pragma("unroll") for (int n = 0; n < 2; ++n) { \
        acc[ai][bj][m][n] = __builtin_amdgcn_mfma_f32_16x16x32_f16(Bt[n][0], At[m][0], (f32x4){0.f, 0.f, 0.f, 0.f}, 0, 0, 0); \
        acc[ai][bj][m][n] = __builtin_amdgcn_mfma_f32_16x16x32_f16(Bt[n][1], At[m][1], acc[ai][bj][m][n], 0, 0, 0); } __builtin_amdgcn_s_setprio(0); } while (0)
#define WAIT_V(n) asm volatile("s_waitcnt vmcnt(" #n ")" ::: "memory")
#define WAIT_L(n) asm volatile("s_waitcnt lgkmcnt(" #n ")" ::: "memory")
#define BAR __builtin_amdgcn_s_barrier()
#define SCHED __builtin_amdgcn_sched_barrier(0)
    Unit cur; int ui = 0;
    cur.row0 = UT(0, 0);
    if (cur.row0 < 0) return;
    cur.col0 = UT(0, 1); cur.pn = UT(0, 2); cur.a = (unsigned)UT(0, 3); cur.b = (unsigned)UT(0, 4);
    f32x4 acc[2][2][4][2];
    h16x8 At[4][2], B0[2][2], B1[2][2];
    unsigned cA = cur.a, cB = cur.b;
    const bool use_ct = (EPI == E_RESID) || ((EPI == E_INPROJ || EPI == E_F16 || EPI == E_SWIGLU) && g.fold);
    const bool use_st = use_ct || EPI == E_QUP || EPI == E_KUP || EPI == E_VTUP;
    const float* const stsrc = (EPI == E_QUP || EPI == E_KUP || EPI == E_VTUP) ? (const float*)(ws + WS_SSQ) : g.st_in;
    const float* const ctA = (EPI == E_RESID) ? g.res : g.cs; const float* const ctB = (EPI == E_RESID) ? g.bias : g.cs + 2 * NCS;
#define STATS_DMA(r0, sel) __builtin_amdgcn_global_load_lds((const unsigned*)(stsrc + (size_t)((r0) + wid * 32 + (lane >> 1)) * 8 + (lane & 1) * 4), (LAS unsigned*)(lds + LDS_STATS + (sel) * 8192 + wid * 1024), 16, 0, 0)
#define COLS_DMA(c0, sel) __builtin_amdgcn_global_load_lds((const unsigned*)((wid == 0 ? ctA : ctB) + (c0) + lane * 4), (LAS unsigned*)(lds + LDS_COLS + (sel) * 2048 + wid * 1024), 16, 0, 0)
    if (use_st) STATS_DMA((EPI == E_VTUP) ? cur.col0 : cur.row0, 0);
    if (use_ct && wid < 2) COLS_DMA(cur.col0, 0);
    STAGE(SB(0, 0), gB, cB, voffB); STAGE(SB(0, 1), gB, cB + hstepB, voffB); STAGE(SA(0, 0), gA, cA, voffA); STAGE(SA(0, 1), gA, cA + hstepA, voffA);
    if (wr == 1) BAR;
    WAIT_V(2); BAR;
    STAGE(SB(1, 0), gB, cB + kstep, voffB); STAGE(SA(1, 0), gA, cA + kstep, voffA); STAGE(SB(1, 1), gB, cB + hstepB + kstep, voffB);
    WAIT_V(6); BAR;
    for (;;) {
        const int nrow0 = (ui + 1 < 32) ? UT(ui + 1, 0) : -1;
        const bool has_next = nrow0 >= 0;
        const unsigned nA = has_next ? (unsigned)UT(ui + 1, 3) : cA, nB = has_next ? (unsigned)UT(ui + 1, 4) : cB;
        { const int t = 0;
            const bool last = (t == nt - 2);
            const unsigned a1 = cA + (unsigned)(t + 1) * kstep;
            const unsigned a2 = last ? nA : cA + (unsigned)(t + 2) * kstep, b2 = last ? nB : cB + (unsigned)(t + 2) * kstep;
            const unsigned a3 = a2 + kstep, b3 = b2 + kstep;
            LDB(B0, 0, 0); LDB(B1, 0, 1); SCHED; LDA(At, 0, 0); STAGE(SA(1, 1), gA, a1 + hstepA, voffA);
            WAIT_V(8); WAIT_L(0); BAR; MMAZ(0, 0, At, B0); MMAZ(0, 1, At, B1); BAR; SCHED;
            LDA(At, 0, 1); STAGE(SB(0, 0), gB, b2, voffB); STAGE(SB(0, 1), gB, b2 + hstepB, voffB); STAGE(SA(0, 0), gA, a2, voffA);
            WAIT_V(8); WAIT_L(0); BAR; MMAZ(1, 0, At, B0); MMAZ(1, 1, At, B1); BAR; SCHED;
            LDB(B0, 1, 0); LDB(B1, 1, 1); SCHED; LDA(At, 1, 0); STAGE(SA(0, 1), gA, a2 + hstepA, voffA);
            WAIT_V(8); WAIT_L(0); BAR; MMA(0, 0, At, B0); MMA(0, 1, At, B1); BAR; SCHED;
            LDA(At, 1, 1); STAGE(SB(1, 0), gB, b3, voffB); STAGE(SB(1, 1), gB, b3 + hstepB, voffB); STAGE(SA(1, 0), gA, a3, voffA);
            WAIT_V(8); WAIT_L(0); BAR; MMA(1, 0, At, B0); MMA(1, 1, At, B1); BAR; SCHED;
        }
        for (int t = 2; t < nt; t += 2) {
            const bool last = (t == nt - 2);
            const unsigned a1 = cA + (unsigned)(t + 1) * kstep;
            const unsigned a2 = last ? nA : cA + (unsigned)(t + 2) * kstep, b2 = last ? nB : cB + (unsigned)(t + 2) * kstep;
            const unsigned a3 = a2 + kstep, b3 = b2 + kstep;
            LDB(B0, 0, 0); LDB(B1, 0, 1); SCHED; LDA(At, 0, 0); STAGE(SA(1, 1), gA, a1 + hstepA, voffA);
            WAIT_V(8); WAIT_L(0); BAR; MMA(0, 0, At, B0); MMA(0, 1, At, B1); BAR; SCHED;
            LDA(At, 0, 1); STAGE(SB(0, 0), gB, b2, voffB); STAGE(SB(0, 1), gB, b2 + hstepB, voffB); STAGE(SA(0, 0), gA, a2, voffA);
            WAIT_V(8); WAIT_L(0); BAR; MMA(1, 0, At, B0); MMA(1, 1, At, B1); BAR; SCHED;
            LDB(B0, 1, 0); LDB(B1, 1, 1); SCHED; LDA(At, 1, 0); STAGE(SA(0, 1), gA, a2 + hstepA, voffA);
            WAIT_V(8); WAIT_L(0); BAR; MMA(0, 0, At, B0); MMA(0, 1, At, B1); BAR; SCHED;
            LDA(At, 1, 1); STAGE(SB(1, 0), gB, b3, voffB); STAGE(SB(1, 1), gB, b3 + hstepB, voffB); STAGE(SA(1, 0), gA, a3, voffA);
            WAIT_V(8); WAIT_L(0); BAR; MMA(1, 0, At, B0); MMA(1, 1, At, B1); BAR; SCHED;
        }
        if (wr == 0) BAR;
        int fr_e = fr, fq_e = fq; asm volatile("" : "+v"(fr_e), "+v"(fq_e));
        epilogue<EPI>(g, cur, acc, wr, wc, fr_e, fq_e, lds, ws, (const LAS float*)(lds + LDS_STATS + (ui & 1) * 8192), (const LAS float*)(lds + LDS_COLS + (ui & 1) * 2048));
        if (has_next) { if (use_st) STATS_DMA((EPI == E_VTUP) ? UT(ui + 1, 1) : nrow0, (ui + 1) & 1); if (use_ct && wid < 2) COLS_DMA(UT(ui + 1, 1), (ui + 1) & 1); }
        if (!has_next) break;
        ++ui;
        cur.row0 = nrow0; cur.col0 = UT(ui, 1); cur.pn = UT(ui, 2); cur.a = nA; cur.b = nB; cA = nA; cB = nB;
        if (wr == 1) BAR;
    }
    WAIT_V(0);
    BAR;
#undef STATS_DMA
#undef COLS_DMA
#undef UT
#undef SA
#undef SB
#undef STAGE
#undef LDA
#undef LDB
#undef MMA
#undef MMAZ
#undef WAIT_V
#undef WAIT_L
#undef BAR
#undef SCHED
}

__device__ const double INV_FREQ[16] = {1.0, 0.5623413251903491, 0.31622776601683794, 0.1778279410038923, 0.1, 0.05623413251903491, 0.03162277660168379,
    0.01778279410038923, 0.01, 0.005623413251903491, 0.0031622776601683794, 0.0017782794100389228, 0.001, 0.0005623413251903491, 0.00031622776601683794, 0.00017782794100389227};

__device__ __forceinline__ void transpose_item(const float* W, int K, int N, h16* WT, int drow, bool rperm, const float* kscale, const float* kbias, float* part, LAS float* scr, int k0, int n0, int lane) {
    { float wv[32];
#pragma unroll
      for (int i = 0; i < 32; ++i) wv[i] = W[(size_t)(k0 + 2 * i + (lane >> 5)) * N + n0 + (lane & 31)];
#pragma unroll
      for (int i = 0; i < 32; ++i) scr[(2 * i + (lane >> 5)) * 33 + (lane & 31)] = wv[i]; }
    asm volatile("s_waitcnt lgkmcnt(0)" ::: "memory");
    const int c = lane & 7;
    float sc[8];
#pragma unroll
    for (int e = 0; e < 8; ++e) sc[e] = kscale ? kscale[k0 + 8 * c + e] : 1.f;
#pragma unroll
    for (int j = 0; j < 4; ++j) { const int n = (lane >> 3) + 8 * j; const LAS float* s = scr + (8 * c) * 33 + n;
        h16x8 o;
#pragma unroll
        for (int e = 0; e < 8; ++e) o[e] = (h16)(s[e * 33] * sc[e]);
        *(h16x8*)(WT + (size_t)(drow + (rperm ? perm32(n) : n)) * K + k0 + 8 * c) = o; }
    if (part) {
        const float myks = kscale[k0 + lane], mykb = kbias[k0 + lane];
        float a = 0.f, b = 0.f; const int n = lane & 31, kh = (lane >> 5) * 32;
#pragma unroll
        for (int kk = 0; kk < 32; ++kk) { const float w = scr[(kh + kk) * 33 + n];
            a += w * __shfl(myks, kh + kk); b += w * __shfl(mykb, kh + kk); }
        a += __shfl_xor(a, 32); b += __shfl_xor(b, 32);
        if (lane < 32) *(f32x2*)(part + ((size_t)(drow + (rperm ? perm32(lane) : lane)) * 16 + (k0 >> 6)) * 2) = (f32x2){a, b};
    }
    asm volatile("s_waitcnt lgkmcnt(0)" ::: "memory");
}

__device__ __forceinline__ void prologue(LAS unsigned char* lds, KP P) {
    const int tid = tid_here(), lane = tid & 63, wave = tid >> 6, bid = bid_here();
    const int G = gridDim.x, gw = bid * 8 + wave, NGW = G * 8;
    const long gt = (long)bid * 512 + tid, NGT = (long)G * 512;
    LAS float* scr = (LAS float*)(lds + wave * 16384);
    constexpr int NJ = 9;
    const int jK[NJ] = {1024, 256, 256, 1024, 1024, 1024, 1024, 1024, 2816};
    const int jN[NJ] = {1568, 768, 1024, 1024, 1024, 2048, 1024, 5632, 1024};
    const int jin[NJ] = {3, 6, 8, 13, 16, 17, 18, 21, 22};
    const size_t jdst[NJ] = {WO_WIN, WO_WUQ, WO_WUK, WO_WO, WO_XWQ, WO_XWKV, WO_XWO, WO_FWIN, WO_FWD};
    int items_per_layer = 0;
#pragma unroll
    for (int j = 0; j < NJ; ++j) items_per_layer += (jK[j] / 64) * (jN[j] / 32);
    for (int it = gw; it < 2 * items_per_layer; it += NGW) {
        const int l = it / items_per_layer; int r = it % items_per_layer; int j = 0;
#pragma unroll
        for (int jj = 0; jj < NJ - 1; ++jj) { const int cnt = (jK[jj] / 64) * (jN[jj] / 32); if (j == jj && r >= cnt) { r -= cnt; j = jj + 1; } }
        int K = 0, N = 0, ini = 0; size_t dsto = 0;
#pragma unroll
        for (int jj = 0; jj < NJ; ++jj) if (j == jj) { K = jK[jj]; N = jN[jj]; ini = jin[jj]; dsto = jdst[jj]; }
        const int nblk = N / 32, kb = r / nblk, nb = r % nblk, n0 = nb * 32;
        int drow = n0; const float* ks = nullptr; const float* kbs = nullptr; float* part = nullptr; bool rperm = false;
        float* partl = (float*)(P->ws + WS_PART) + (size_t)l * NCS * 32;
        if (j == 0) { drow = n0 < 512 ? n0 : (n0 < 544 ? 1536 + (n0 - 512) : n0 - 32); rperm = (n0 == 512); if (l > 0) { ks = P->in[23] + (l - 1) * DM; kbs = P->in[24] + (l - 1) * DM; part = partl; } }
        else if (j == 4) { ks = P->in[14] + l * DM; kbs = P->in[15] + l * DM; part = partl + (size_t)1792 * 32; }
        else if (j == 1) { ks = P->in[5] + l * 256; rperm = (nb % 3 == 2); }
        else if (j == 2) { const int h = nb >> 2, part = nb & 3; drow = part < 2 ? h * 64 + 32 * part : 512 + h * 64 + 32 * (part - 2); ks = P->in[7] + l * 256; }
        else if (j == 7) { const int jj = n0 < FFH ? n0 : n0 - FFH; drow = (jj >> 7) * 256 + (jj & 127) + (n0 < FFH ? 0 : 128); ks = P->in[19] + l * DM; kbs = P->in[20] + l * DM; part = partl + (size_t)(1792 + 1024) * 32; }
        transpose_item(P->in[ini] + (size_t)l * K * N, K, N, (h16*)(P->ws + WS_W + (size_t)l * 32 * MiB) + dsto, drow, rperm, ks, kbs, part, scr, kb * 64, n0, lane);
    }
    for (long i = gt; i < 2L * 224 * 1024 / 8; i += NGT) { const int l = (int)(i / (224 * 1024 / 8)); const long r = i % (224 * 1024 / 8);
        unsigned zz = 0; asm volatile("" : "+v"(zz));
        *(u32x4*)((h16*)(P->ws + WS_W + (size_t)l * 32 * MiB) + WO_WIN + (size_t)1568 * 1024 + r * 8) = (u32x4){zz, zz, zz, zz}; }
    for (long i = gt; i < 2 * 1792; i += NGT) { const int l = (int)(i / 1792), r = (int)(i % 1792);
        const int src = r < 512 ? r : (r < 1536 ? r + 32 : (r < 1568 ? 512 + (r - 1536) : -1));
        ((float*)(P->ws + WS_BIAS))[i] = src >= 0 ? P->in[4][l * 1568 + src] : 0.f; }
    for (long i = gt; i < (long)TT * 16; i += NGT) { const int tok = (int)(i >> 4), f = (int)(i & 15);
        const double ang = (double)P->pos[tok] * INV_FREQ[f];
        const double kq = __builtin_rint(ang * 0.6366197723675814); const double r = (ang - kq * 1.5707963267948966) - kq * 6.123233995736766e-17;
        const double r2 = r * r;
        const double sn = r * (1.0 + r2 * (-1.0 / 6 + r2 * (1.0 / 120 + r2 * (-1.0 / 5040 + r2 * (1.0 / 362880 + r2 * (-1.0 / 39916800))))));
        const double cs = 1.0 + r2 * (-0.5 + r2 * (1.0 / 24 + r2 * (-1.0 / 720 + r2 * (1.0 / 40320 + r2 * (-1.0 / 3628800 + r2 * (1.0 / 479001600))))));
        const int q = (int)((long long)kq & 3);
        const double c = q == 0 ? cs : (q == 1 ? -sn : (q == 2 ? -cs : sn));
        const double s = q == 0 ? sn : (q == 1 ? cs : (q == 2 ? -sn : -cs));
        ((float*)(P->ws + WS_COS))[i] = (float)c; ((float*)(P->ws + WS_SIN))[i] = (float)s; }
    {
        const long n8x = (long)TT * DM / 8, n8m = (long)MEMT * DM / 8;
        for (int pass = 0; pass < 2; ++pass) {
            const f32x4* src = (const f32x4*)(pass == 0 ? P->in[0] : P->in[1]); h16x8* dst = (h16x8*)(P->ws + (pass == 0 ? WS_XH : WS_MEMH)); const long n8 = pass == 0 ? n8x : n8m;
            for (long i = gt; i < n8; i += 4 * NGT) {
                f32x4 a[4], b[4];
#pragma unroll
                for (int q = 0; q < 4; ++q) { const long ii = i + q * NGT; if (ii < n8) { a[q] = src[2 * ii]; b[q] = src[2 * ii + 1]; } }
#pragma unroll
                for (int q = 0; q < 4; ++q) { const long ii = i + q * NGT; if (ii < n8) { h16x8 o; o[0] = (h16)a[q][0]; o[1] = (h16)a[q][1]; o[2] = (h16)a[q][2]; o[3] = (h16)a[q][3]; o[4] = (h16)b[q][0]; o[5] = (h16)b[q][1]; o[6] = (h16)b[q][2]; o[7] = (h16)b[q][3]; dst[ii] = o; } }
            }
        }
    }
}

__device__ __forceinline__ void csbw_finalize(KP P) {
    const long gt = (long)bid_here() * 512 + tid_here(), NGT = (long)gridDim.x * 512;
    const float* part = (const float*)(P->ws + WS_PART); float* cs = (float*)(P->ws + WS_CSBW);
    for (long i = gt; i < 2L * NCS; i += NGT) { const int c = (int)(i % NCS); float a = 0.f, b = 0.f;
        if (!(c >= 1568 && c < 1792) && !(i < 1792)) {
            const f32x2* p = (const f32x2*)part + i * 16;
#pragma unroll
            for (int k = 0; k < 16; ++k) { const f32x2 v = p[k]; a += v[0]; b += v[1]; } }
        cs[i] = a; cs[2 * NCS + i] = b; }
}
__device__ __forceinline__ void ln_final(KP P, const float* gam, const float* bet) {
    const int tid = tid_here(), lane = tid & 63, wave = tid >> 6;
    const int gw = bid_here() * 8 + wave, NGW = gridDim.x * 8;
    f32x4 gv[4], bv[4];
#pragma unroll
    for (int j = 0; j < 2; ++j) { gv[2 * j] = ((const f32x4*)gam)[128 * j + 2 * lane]; gv[2 * j + 1] = ((const f32x4*)gam)[128 * j + 2 * lane + 1];
                                  bv[2 * j] = ((const f32x4*)bet)[128 * j + 2 * lane]; bv[2 * j + 1] = ((const f32x4*)bet)[128 * j + 2 * lane + 1]; }
    h16x8 z[2][2], zn[2][2];
#define LN_LOAD(dst, r0) do { _Pragma("unroll") for (int r = 0; r < 2; ++r) _Pragma("unroll") for (int j = 0; j < 2; ++j) \
        dst[r][j] = ((const h16x8*)((const h16*)(P->ws + WS_XH) + (size_t)((r0) + r) * DM))[64 * j + lane]; } while (0)
    if (gw * 2 < TT) LN_LOAD(z, gw * 2);
    for (int row0 = gw * 2; row0 < TT; row0 += NGW * 2) {
        const bool more = row0 + NGW * 2 < TT;
        if (more) LN_LOAD(zn, row0 + NGW * 2);
#pragma unroll
        for (int r = 0; r < 2; ++r) {
            f32x4 v[4]; float s = 0.f;
#pragma unroll
            for (int j = 0; j < 2; ++j) { v[2 * j] = (f32x4){(float)z[r][j][0], (float)z[r][j][1], (float)z[r][j][2], (float)z[r][j][3]}; v[2 * j + 1] = (f32x4){(float)z[r][j][4], (float)z[r][j][5], (float)z[r][j][6], (float)z[r][j][7]}; }
#pragma unroll
            for (int j = 0; j < 4; ++j) s += (v[j][0] + v[j][1]) + (v[j][2] + v[j][3]);
            const float mean = wave_sum(s) * (1.f / DM); float s2 = 0.f;
#pragma unroll
            for (int j = 0; j < 4; ++j) { v[j] = v[j] - mean; s2 += (v[j][0] * v[j][0] + v[j][1] * v[j][1]) + (v[j][2] * v[j][2] + v[j][3] * v[j][3]); }
            const float rstd = 1.f / sqrtf(wave_sum(s2) * (1.f / DM) + 1e-5f);
            f32x4* xr = (f32x4*)(P->out + (size_t)(row0 + r) * DM);
#pragma unroll
            for (int j = 0; j < 2; ++j) { xr[128 * j + 2 * lane] = v[2 * j] * rstd * gv[2 * j] + bv[2 * j]; xr[128 * j + 2 * lane + 1] = v[2 * j + 1] * rstd * gv[2 * j + 1] + bv[2 * j + 1]; }
        }
        if (more) {
#pragma unroll
            for (int r = 0; r < 2; ++r)
#pragma unroll
                for (int j = 0; j < 2; ++j) z[r][j] = zn[r][j]; }
    }
#undef LN_LOAD
}

__device__ __forceinline__ void conv_phase(LAS unsigned char* lds, KP P, int l) {
    const int tid = tid_here(), lane = tid & 63, wave = tid >> 6;
    const h16* PROJ = (const h16*)(P->ws + WS_PROJ); h16* YC = (h16*)(P->ws + WS_YCAT);
    LAS unsigned* hp = (LAS unsigned*)lds;
    LAS float* cb = (LAS float*)(lds + 65536);
    h16x2 wE[16], wO[16];
    { float w[31];
#pragma unroll
      for (int j = 0; j < 31; ++j) w[j] = P->in[9][(size_t)l * 31 * 512 + j * 512 + tid];
#pragma unroll
      for (int i = 0; i < 15; ++i) { wE[i] = (h16x2){(h16)w[2 * i], (h16)w[2 * i + 1]}; wO[i + 1] = (h16x2){(h16)w[2 * i + 1], (h16)w[2 * i + 2]}; }
      wE[15] = (h16x2){(h16)w[30], (h16)0.f}; wO[0] = (h16x2){(h16)0.f, (h16)w[0]}; }
    const float bias = P->in[10][l * 512 + tid];
    f32x4 ng[2], nbv[2];
#pragma unroll
    for (int j = 0; j < 2; ++j) { ng[j] = *(const f32x4*)(P->in[11] + l * 512 + lane * 8 + 4 * j); nbv[j] = *(const f32x4*)(P->in[12] + l * 512 + lane * 8 + 4 * j); }
    h16x8 ra0[4], rg0[4], ra1[4], rg1[4];
#define CONV_LOAD(uu) do { const int b_ = (uu) >> 6, t0_ = ((uu) & 63) * 32; \
        _Pragma("unroll") for (int k_ = 0; k_ < 4; ++k_) { const int idx_ = tid + 512 * k_; const int pr_ = idx_ >> 6, c8_ = idx_ & 63, tok_ = t0_ - 30 + 2 * pr_; \
            if (idx_ < 31 * 64 && tok_ >= 0) { const h16* src_ = PROJ + (size_t)(b_ * SEQ + tok_) * PROJW + 512 + c8_ * 8; \
                ra0[k_] = *(const h16x8*)src_; rg0[k_] = *(const h16x8*)(src_ + 512); ra1[k_] = *(const h16x8*)(src_ + PROJW); rg1[k_] = *(const h16x8*)(src_ + PROJW + 512); } } } while (0)
#define CONV_GLU(uu) do { const int t0_ = ((uu) & 63) * 32; \
        _Pragma("unroll") for (int k_ = 0; k_ < 4; ++k_) { const int idx_ = tid + 512 * k_; const int pr_ = idx_ >> 6, c8_ = idx_ & 63, tok_ = t0_ - 30 + 2 * pr_; \
            if (idx_ < 31 * 64) { u32x4 d0_ = {0u, 0u, 0u, 0u}, d1_ = {0u, 0u, 0u, 0u}; \
                if (tok_ >= 0) { \
                    _Pragma("unroll") for (int e = 0; e < 8; ++e) { \
                        const float h0_ = (float)ra0[k_][e] * __builtin_amdgcn_rcpf(1.f + fast_exp2((float)rg0[k_][e] * -1.4426950408889634f)); \
                        const float h1_ = (float)ra1[k_][e] * __builtin_amdgcn_rcpf(1.f + fast_exp2((float)rg1[k_][e] * -1.4426950408889634f)); \
                        const h16x2 pk_ = {(h16)h0_, (h16)h1_}; const unsigned w_ = __builtin_bit_cast(unsigned, pk_); \
                        if (e < 4) d0_[e] = w_; else d1_[e - 4] = w_; } } \
                *(LAS u32x4*)(hp + pr_ * 512 + c8_ * 8) = d0_; *(LAS u32x4*)(hp + pr_ * 512 + c8_ * 8 + 4) = d1_; } } } while (0)
    const int u_first = bid_here();
    if (u_first < TT / 32) { CONV_LOAD(u_first); CONV_GLU(u_first); }
    LDS_BARRIER();
    for (int u = u_first; u < TT / 32; u += gridDim.x) {
        const int b = u >> 6, t0 = (u & 63) * 32;
        const int un = u + gridDim.x; const bool has_next = un < TT / 32;
        if (has_next) CONV_LOAD(un);
        for (int m = 0; m < 16; ++m) {
            float a0 = bias, a1 = bias;
#pragma unroll
            for (int i = 0; i < 16; ++i) { const h16x2 p = __builtin_bit_cast(h16x2, hp[(m + i) * 512 + tid]);
                a0 = __builtin_amdgcn_fdot2(p, wE[i], a0, false); a1 = __builtin_amdgcn_fdot2(p, wO[i], a1, false); }
            cb[(2 * m) * 512 + tid] = a0; cb[(2 * m + 1) * 512 + tid] = a1;
        }
        LDS_BARRIER();
        if (has_next) CONV_GLU(un);
#pragma unroll
        for (int k = 0; k < 4; ++k) {
            const int lt = wave * 4 + k;
            f32x4 v0 = *(const LAS f32x4*)(cb + lt * 512 + lane * 8), v1 = *(const LAS f32x4*)(cb + lt * 512 + lane * 8 + 4);
            const float mean = wave_sum((v0[0] + v0[1]) + (v0[2] + v0[3]) + (v1[0] + v1[1]) + (v1[2] + v1[3])) * (1.f / 512.f);
            v0 = v0 - mean; v1 = v1 - mean;
            const float var = wave_sum((v0[0] * v0[0] + v0[1] * v0[1]) + (v0[2] * v0[2] + v0[3] * v0[3]) + (v1[0] * v1[0] + v1[1] * v1[1]) + (v1[2] * v1[2] + v1[3] * v1[3])) * (1.f / 512.f);
            const float rstd = 1.f / sqrtf(var + 1e-5f);
            v0 = v0 * rstd * ng[0] + nbv[0]; v1 = v1 * rstd * ng[1] + nbv[1];
            h16x8 o;
#pragma unroll
            for (int e = 0; e < 4; ++e) { o[e] = (h16)(v0[e] * __builtin_amdgcn_rcpf(1.f + fast_exp2(v0[e] * -1.4426950408889634f))); o[4 + e] = (h16)(v1[e] * __builtin_amdgcn_rcpf(1.f + fast_exp2(v1[e] * -1.4426950408889634f))); }
            *(h16x8*)(YC + (size_t)(b * SEQ + t0 + lt) * DM + 512 + lane * 8) = o;
        }
        LDS_BARRIER();
    }
#undef CONV_LOAD
#undef CONV_GLU
}

constexpr int KPITCH = 208, VPITCH = 264;
__device__ __forceinline__ void attn_phase(LAS unsigned char* lds, KP P) {
    const int tid = tid_here(), lane = tid & 63, r32 = lane & 31, hi = lane >> 5; const int wid = __builtin_amdgcn_readfirstlane(tid >> 6);
    const h16* Q = (const h16*)(P->ws + WS_Q); const h16* KN = (const h16*)(P->ws + WS_KN); const h16* KR = (const h16*)(P->ws + WS_KR);
    const h16* VT = (const h16*)(P->ws + WS_VT); h16* YC = (h16*)(P->ws + WS_YCAT);
    LAS unsigned char* Kb = lds; LAS unsigned char* Vb = lds + 2 * 128 * KPITCH; LAS unsigned char* Sg = lds + 2 * 128 * KPITCH + 2 * 64 * VPITCH + wid * (32 * 144);
    u32x4 sk[3], sv[2];
#define LOADT(J, rowbase_, h_) do { const size_t kb_ = (rowbase_) + 128 * (J); \
        _Pragma("unroll") for (int i_ = 0; i_ < 3; ++i_) { const int c_ = tid + 512 * i_, kr_ = c_ / 12, kc_ = c_ % 12; \
            sk[i_] = kc_ < 8 ? *(const u32x4*)(KN + (kb_ + kr_) * 512 + (h_) * 64 + kc_ * 8) : *(const u32x4*)(KR + (kb_ + kr_) * 32 + (kc_ - 8) * 8); } \
        _Pragma("unroll") for (int i_ = 0; i_ < 2; ++i_) { const int c_ = tid + 512 * i_; \
            sv[i_] = *(const u32x4*)(VT + (size_t)((h_) * 64 + (c_ >> 4)) * TT + kb_ + (c_ & 15) * 8); } } while (0)
#define STORET(buf) do { \
        _Pragma("unroll") for (int i_ = 0; i_ < 3; ++i_) { const int c_ = tid + 512 * i_, kr_ = c_ / 12, kc_ = c_ % 12; \
            *(LAS u32x4*)(Kb + (buf) * 128 * KPITCH + kr_ * KPITCH + kc_ * 16) = sk[i_]; } \
        _Pragma("unroll") for (int i_ = 0; i_ < 2; ++i_) { const int c_ = tid + 512 * i_; LAS unsigned char* vd_ = Vb + (buf) * 64 * VPITCH + (c_ >> 4) * VPITCH + (c_ & 15) * 16; \
            *(LAS unsigned long long*)vd_ = ((unsigned long long)sv[i_][1] << 32) | sv[i_][0]; \
            *(LAS unsigned long long*)(vd_ + 8) = ((unsigned long long)sv[i_][3] << 32) | sv[i_][2]; } } while (0)
#define LOADQ(dst, u_) do { const int bh_ = (u_) & 255, qb_ = 7 - ((u_) >> 8); \
        const h16* qp_ = Q + ((size_t)(bh_ >> 3) * SEQ + qb_ * 256 + wid * 32 + r32) * 768 + (bh_ & 7) * 96 + 8 * hi; \
        _Pragma("unroll") for (int d0 = 0; d0 < 6; ++d0) dst[d0] = *(const h16x8*)(qp_ + 16 * d0); } while (0)
    h16x8 qf[6];
    const int u_first = bid_here();
    if (u_first < 2048) { LOADQ(qf, u_first); LOADT(0, (size_t)((u_first & 255) >> 3) * SEQ, (u_first & 255) & 7); STORET(0); }
    LDS_BARRIER();
    for (int u = u_first; u < 2048; u += gridDim.x) {
        const int bh = u & 255, qb = 7 - (u >> 8), b = bh >> 3, h = bh & 7;
        const size_t rowbase = (size_t)b * SEQ; const int q0 = qb * 256, NT2 = 2 * qb + 2, my_last = 4 * qb + (wid >> 1);
        const int un = u + gridDim.x; const bool has_next = un < 2048;
        const size_t rowbase_n = (size_t)((un & 255) >> 3) * SEQ; const int h_n = (un & 255) & 7;
        f32x16 o0, o1; float m_run = -INFINITY, lsum = 0.f;
#pragma unroll
        for (int r = 0; r < 16; ++r) { o0[r] = 0.f; o1[r] = 0.f; }
        auto compute = [&](const LAS unsigned char* kbase, const LAS unsigned char* vbase) {
                f32x16 p0, p1;
#pragma unroll
                for (int r = 0; r < 16; ++r) { p0[r] = 0.f; p1[r] = 0.f; }
                const LAS unsigned char* kp = kbase + r32 * KPITCH + hi * 16;
                const LAS unsigned char* vp = vbase + r32 * VPITCH + hi * 8;
                h16x8 kf[12];
#pragma unroll
                for (int d0 = 0; d0 < 6; ++d0) { kf[2 * d0] = *(const LAS h16x8*)(kp + d0 * 32); kf[2 * d0 + 1] = *(const LAS h16x8*)(kp + 32 * KPITCH + d0 * 32); }
                __builtin_amdgcn_sched_barrier(0);
#pragma unroll
                for (int d0 = 0; d0 < 6; ++d0) {
                    p0 = __builtin_amdgcn_mfma_f32_32x32x16_f16(kf[2 * d0], qf[d0], p0, 0, 0, 0);
                    p1 = __builtin_amdgcn_mfma_f32_32x32x16_f16(kf[2 * d0 + 1], qf[d0], p1, 0, 0, 0);
                }
                h16x4 vf[4][4];
#pragma unroll
                for (int t = 0; t < 4; ++t) { const int kbyte = (32 * (t >> 1) + 16 * (t & 1)) * 2;
                    vf[t][0] = *(const LAS h16x4*)(vp + kbyte); vf[t][1] = *(const LAS h16x4*)(vp + kbyte + 16);
                    vf[t][2] = *(const LAS h16x4*)(vp + 32 * VPITCH + kbyte); vf[t][3] = *(const LAS h16x4*)(vp + 32 * VPITCH + kbyte + 16); }
                __builtin_amdgcn_sched_barrier(0);
                float mx = fmaxf(p0[0], p1[0]);
#pragma unroll
                for (int r = 1; r < 16; ++r) mx = fmaxf(mx, fmaxf(p0[r], p1[r]));
                mx = fmaxf(mx, __shfl_xor(mx, 32));
                const float m_new = fmaxf(m_run, mx), alpha = fast_exp2(m_run - m_new); m_run = m_new;
                float ps = 0.f;
#pragma unroll
                for (int r = 0; r < 16; ++r) { p0[r] = fast_exp2(p0[r] - m_new); p1[r] = fast_exp2(p1[r] - m_new); ps += p0[r] + p1[r]; }
                lsum = lsum * alpha + ps;
#pragma unroll
                for (int r = 0; r < 16; ++r) { o0[r] *= alpha; o1[r] *= alpha; }
                h16x8 pb[4];
#pragma unroll
                for (int e = 0; e < 8; ++e) { pb[0][e] = (h16)p0[e]; pb[1][e] = (h16)p0[8 + e]; pb[2][e] = (h16)p1[e]; pb[3][e] = (h16)p1[8 + e]; }
#pragma unroll
                for (int t = 0; t < 4; ++t) {
                    const h16x8 va = {vf[t][0][0], vf[t][0][1], vf[t][0][2], vf[t][0][3], vf[t][1][0], vf[t][1][1], vf[t][1][2], vf[t][1][3]};
                    const h16x8 vc2 = {vf[t][2][0], vf[t][2][1], vf[t][2][2], vf[t][2][3], vf[t][3][0], vf[t][3][1], vf[t][3][2], vf[t][3][3]};
                    o0 = __builtin_amdgcn_mfma_f32_32x32x16_f16(va, pb[t], o0, 0, 0, 0);
                    o1 = __builtin_amdgcn_mfma_f32_32x32x16_f16(vc2, pb[t], o1, 0, 0, 0);
                }
        };
        for (int J = 0; J < NT2; ++J) {
            const int buf = J & 1;
            if (J + 1 < NT2) LOADT(J + 1, rowbase, h);
            else if (has_next) LOADT(0, rowbase_n, h_n);
            if (2 * J <= my_last) compute(Kb + buf * 128 * KPITCH, Vb + buf * 64 * VPITCH);
            if (2 * J + 1 <= my_last) compute(Kb + buf * 128 * KPITCH + 64 * KPITCH, Vb + buf * 64 * VPITCH + 128);
            if (J + 1 == NT2 && has_next) LOADQ(qf, un);
            if (J + 1 < NT2 || has_next) STORET(buf ^ 1);
            LDS_BARRIER();
        }
        lsum += __shfl_xor(lsum, 32);
        const float inv = 1.f / lsum;
        LAS h16* sg = (LAS h16*)Sg;
#pragma unroll
        for (int r = 0; r < 16; ++r) { const int d = (r & 3) + 8 * (r >> 2) + 4 * hi; sg[r32 * 72 + d] = (h16)(o0[r] * inv); sg[r32 * 72 + 32 + d] = (h16)(o1[r] * inv); }
        asm volatile("s_waitcnt lgkmcnt(0)" ::: "memory");
#pragma unroll
        for (int i = 0; i < 4; ++i) { const int id = i * 64 + lane, row = id >> 3, c = id & 7;
            const u32x4 v = *(const LAS u32x4*)(Sg + row * 144 + c * 16);
            *(u32x4*)(YC + (rowbase + q0 + wid * 32 + row) * DM + h * 64 + c * 8) = v; }
        asm volatile("s_waitcnt lgkmcnt(0)" ::: "memory");
    }
#undef LOADT
#undef STORET
#undef LOADQ
}


#define XB_TMO      128
#define XB_XCNT(j)  (256  + 64 * (j))
#define XB_XSUB(j)  (1280 + 64 * (j))
#define XB_XGEN(j)  (2304 + 64 * (j))
#define XB_TOP      3328
#define XB_TOPGEN   3392
#define XCD_BAR_WORDS 3456
#define XB_SPIN_CAP (1u << 18)
__device__ __forceinline__ unsigned xb_ld(unsigned* p)              { return __hip_atomic_load(p, __ATOMIC_RELAXED, __HIP_MEMORY_SCOPE_AGENT); }
__device__ __forceinline__ unsigned xb_add(unsigned* p, unsigned v) { return __hip_atomic_fetch_add(p, v, __ATOMIC_RELAXED, __HIP_MEMORY_SCOPE_AGENT); }
__device__ __forceinline__ unsigned xb_xcc_id() { return (unsigned)__builtin_amdgcn_s_getreg((3 << 11) | 20) & 0xFu; }
#define XB_SPIN(cond, bar) do { unsigned _sp = 0; while (cond) { __builtin_amdgcn_s_sleep(1); \
    if ((++_sp & 255u) == 0u) { if (xb_ld(&(bar)[XB_TMO])) break; if (_sp > XB_SPIN_CAP) { atomicAdd(&(bar)[XB_TMO], 1u); break; } } } } while (0)
struct XcdBarrier { unsigned* bar; unsigned x; volatile LAS unsigned* st; };
__device__ __forceinline__ XcdBarrier xcd_barrier_post(unsigned* bar, volatile LAS unsigned* st) {
    XcdBarrier b; b.bar = bar; b.x = xb_xcc_id(); b.st = st;
    if (threadIdx.x == 0) (void)xb_add(&bar[XB_XCNT(b.x)], 1u);
    return b;
}
__device__ __forceinline__ void xcd_barrier_complete(unsigned* bar, unsigned x, unsigned& nloc, unsigned& nx) {
    const unsigned G = gridDim.x * gridDim.y * gridDim.z;
    unsigned sum, cnt, mine, sp = 0u;
    for (;;) {
        sum = 0u; cnt = 0u; mine = 0u;
#pragma unroll
        for (unsigned j = 0; j < 16; ++j) { const unsigned c = xb_ld(&bar[XB_XCNT(j)]); sum += c; cnt += (c > 0u) ? 1u : 0u; mine = (j == x) ? c : mine; }
        if (sum == G) break;
        __builtin_amdgcn_s_sleep(1);
        if ((++sp & 255u) == 0u) { if (xb_ld(&bar[XB_TMO])) break; if (sp > XB_SPIN_CAP) { atomicAdd(&bar[XB_TMO], 1u); break; } }
    }
    nloc = mine > 0u ? mine : 1u; nx = cnt > 0u ? cnt : 1u;
}
__device__ __forceinline__ void xcd_barrier(const XcdBarrier& b) {
    asm volatile("s_waitcnt vmcnt(0)" ::: "memory");
    __syncthreads();
    if (threadIdx.x == 0) {
        unsigned* bar = (unsigned*)(kparams()->ws + WS_BAR); asm volatile("" : "+v"(bar));
        __builtin_amdgcn_s_waitcnt(0);
        unsigned nloc = b.st[0], nx = b.st[1];
        if (nloc == 0u) { xcd_barrier_complete(bar, b.x, nloc, nx); b.st[0] = nloc; b.st[1] = nx; }
        const unsigned old = xb_add(&bar[XB_XSUB(b.x)], 1u);
        const unsigned gen = old / nloc;
        if (old + 1u == (gen + 1u) * nloc) {
            __builtin_amdgcn_fence(__ATOMIC_RELEASE, "agent");
            asm volatile("s_waitcnt vmcnt(0)" ::: "memory");
            const unsigned og = xb_add(&bar[XB_TOP], 1u);
            const unsigned tg = og / nx;
            if (og + 1u == (tg + 1u) * nx) xb_add(&bar[XB_TOPGEN], 1u);
            else XB_SPIN(xb_ld(&bar[XB_TOPGEN]) == tg, bar);
            __builtin_amdgcn_fence(__ATOMIC_ACQUIRE, "agent");
            xb_add(&bar[XB_XGEN(b.x)], 1u);
            asm volatile("s_waitcnt vmcnt(0)" ::: "memory");
        } else {
            XB_SPIN(xb_ld(&bar[XB_XGEN(b.x)]) == gen, bar);
            __builtin_amdgcn_fence(__ATOMIC_ACQUIRE, "agent");
            asm volatile("s_waitcnt vmcnt(0)" ::: "memory");
        }
    }
    __syncthreads();
}

struct GT { unsigned long long a, b, o; int lda, ldb, K, nM, nN, nZ1, nZ2, a_s1, a_s2, b_s1, b_s2, epi, ldc, rkind, bias, fold, st_in, st_out, cs, gidx, gl; float scale; int ph; };
__device__ const GT GTAB[] = {
    {WS_MEMH, WS_W + 0ull * 32 * MiB + WO_XWKV * 2, WS_XK, 1024, 1024, 1024, 32, 4, 1, 2, 0, 0, 0, 16777216, E_F16, 2048, 0, -1, 0, 0, 0, 0, 0, 0, 1.f, 1},
    {WS_W + 0ull * 32 * MiB + (WO_XWKV + 1024 * 1024) * 2, WS_MEMH, WS_XVT, 1024, 1024, 1024, 4, 32, 2, 1, 16777216, 0, 0, 0, E_F16, MEMT, 0, -1, 0, 0, 0, 0, 0, 0, 1.f, 1},
    {WS_XH, WS_W + 0ull * 32 * MiB + WO_WIN * 2, WS_PROJ, 1024, 1024, 1024, 256, 7, 1, 1, 0, 0, 0, 0, E_INPROJ, 0, 0, (int)WS_BIAS, 0, 0, 0, 0, 0, 0, 1.f, 1},
    {WS_PROJ, WS_W + 0ull * 32 * MiB + WO_WUQ * 2, WS_Q, PROJW, 256, 256, 256, 3, 1, 1, 0, 0, 0, 0, E_QUP, 0, 0, -1, 0, 0, 0, 0, 0, 0, 1.f, 3},
    {WS_PROJ + 512, WS_W + 0ull * 32 * MiB + WO_WUK * 2, WS_KN, PROJW, 256, 256, 256, 2, 1, 1, 0, 0, 0, 0, E_KUP, 0, 0, -1, 0, 0, 0, 0, 0, 0, 1.f, 3},
    {WS_W + 0ull * 32 * MiB + WO_WUV * 2, WS_PROJ + 512, WS_VT, 256, PROJW, 256, 2, 256, 1, 1, 0, 0, 0, 0, E_VTUP, 0, 0, -1, 0, 0, 0, 0, 0, 0, 1.f, 3},
    {WS_YCAT, WS_W + 0ull * 32 * MiB + WO_WO * 2, 0, 1024, 1024, 1024, 256, 4, 1, 1, 0, 0, 0, 0, E_RESID0, 0, 1, -1, 0, 0, 0, 0, 0, 0, 1.f, 5},
    {WS_XH, WS_W + 0ull * 32 * MiB + WO_XWQ * 2, WS_XQ, 1024, 1024, 1024, 256, 4, 1, 1, 0, 0, 0, 0, E_F16, 1024, 0, -1, 1, 0, 0, 0 * NCS + 1792, 0, 0, XQSCALE, 7},
    {WS_XQ, WS_XK + 0 * 2048, WS_P, 1024, 2048, 256, 8, 1, 32, 4, SEQ * 1024, 256, 256 * 2048, 256, E_SOFTMAX, 0, 0, -1, 0, 0, 0, 0, 0, 0, 1.f, 8},
    {WS_P, WS_XVT + 0ull * 16 * MiB, WS_XO, 1024, MEMT, 256, 8, 1, 32, 4, SEQ * 1024, 256, 256, 256 * MEMT, E_F16, 1024, 0, -1, 0, 0, 0, 0, 0, 0, 1.f, 9},
    {WS_XO, WS_W + 0ull * 32 * MiB + WO_XWO * 2, 0, 1024, 1024, 1024, 256, 4, 1, 1, 0, 0, 0, 0, E_RESID, 0, 2, -1, 1, 0, 1, 0, 14, 0, 1.f, 10},
    {WS_XH, WS_W + 0ull * 32 * MiB + WO_FWIN * 2, WS_H, 1024, 1024, 1024, 256, 22, 1, 1, 0, 0, 0, 0, E_SWIGLU, 0, 0, -1, 1, 1, 0, 0 * NCS + 2816, 0, 0, 1.f, 12},
    {WS_H, WS_W + 0ull * 32 * MiB + WO_FWD * 2, 0, FFH, FFH, FFH, 256, 4, 1, 1, 0, 0, 0, 0, E_RESID, 0, 2, -1, 1, 1, 0, 0, 19, 0, 1.f, 13},
    {WS_XH, WS_W + 1ull * 32 * MiB + WO_WIN * 2, WS_PROJ, 1024, 1024, 1024, 256, 7, 1, 1, 0, 0, 0, 0, E_INPROJ, 0, 0, (int)WS_BIAS + 1 * 1792 * 4, 1, 0, 0, 1 * NCS, 0, 0, 1.f, 15},
    {WS_PROJ, WS_W + 1ull * 32 * MiB + WO_WUQ * 2, WS_Q, PROJW, 256, 256, 256, 3, 1, 1, 0, 0, 0, 0, E_QUP, 0, 0, -1, 0, 0, 0, 0, 0, 0, 1.f, 16},
    {WS_PROJ + 512, WS_W + 1ull * 32 * MiB + WO_WUK * 2, WS_KN, PROJW, 256, 256, 256, 2, 1, 1, 0, 0, 0, 0, E_KUP, 0, 0, -1, 0, 0, 0, 0, 0, 0, 1.f, 16},
    {WS_W + 1ull * 32 * MiB + WO_WUV * 2, WS_PROJ + 512, WS_VT, 256, PROJW, 256, 2, 256, 1, 1, 0, 0, 0, 0, E_VTUP, 0, 0, -1, 0, 0, 0, 0, 0, 0, 1.f, 16},
    {WS_YCAT, WS_W + 1ull * 32 * MiB + WO_WO * 2, 0, 1024, 1024, 1024, 256, 4, 1, 1, 0, 0, 0, 0, E_RESID, 0, 2, -1, 1, 0, 1, 0, 23, 0, 1.f, 18},
    {WS_XH, WS_W + 1ull * 32 * MiB + WO_XWQ * 2, WS_XQ, 1024, 1024, 1024, 256, 4, 1, 1, 0, 0, 0, 0, E_F16, 1024, 0, -1, 1, 1, 0, 1 * NCS + 1792, 0, 0, XQSCALE, 20},
    {WS_XQ, WS_XK + 1 * 2048, WS_P, 1024, 2048, 256, 8, 1, 32, 4, SEQ * 1024, 256, 256 * 2048, 256, E_SOFTMAX, 0, 0, -1, 0, 0, 0, 0, 0, 0, 1.f, 21},
    {WS_P, WS_XVT + 1ull * 16 * MiB, WS_XO, 1024, MEMT, 256, 8, 1, 32, 4, SEQ * 1024, 256, 256, 256 * MEMT, E_F16, 1024, 0, -1, 0, 0, 0, 0, 0, 0, 1.f, 22},
    {WS_XO, WS_W + 1ull * 32 * MiB + WO_XWO * 2, 0, 1024, 1024, 1024, 256, 4, 1, 1, 0, 0, 0, 0, E_RESID, 0, 2, -1, 1, 1, 0, 0, 14, 1, 1.f, 23},
    {WS_XH, WS_W + 1ull * 32 * MiB + WO_FWIN * 2, WS_H, 1024, 1024, 1024, 256, 22, 1, 1, 0, 0, 0, 0, E_SWIGLU, 0, 0, -1, 1, 0, 0, 1 * NCS + 2816, 0, 0, 1.f, 25},
    {WS_H, WS_W + 1ull * 32 * MiB + WO_FWD * 2, 0, FFH, FFH, FFH, 256, 4, 1, 1, 0, 0, 0, 0, E_RESID, 0, 2, -1, 1, 0, 1, 0, 19, 1, 1.f, 26},
    {0, 0, 0, 0, 0, 0, 0, 0, 0, 0, 0, 0, 0, 0, 0, 0, 0, 0, 0, 0, 0, 0, 0, 0, 0.f, 99},
};
__device__ __forceinline__ void load_gemm(GemmDesc& g, int ti, KP P) {
    const GT& t = GTAB[ti]; unsigned char* ws = P->ws;
    g.A = (const h16*)(ws + t.a); g.B = (const h16*)(ws + t.b); g.lda = t.lda; g.ldb = t.ldb; g.K = t.K; g.nM = t.nM; g.nN = t.nN; g.nZ1 = t.nZ1; g.nZ2 = t.nZ2;
    g.a_s1 = t.a_s1; g.a_s2 = t.a_s2; g.b_s1 = t.b_s1; g.b_s2 = t.b_s2; g.epi = t.epi; g.ldc = t.ldc; g.scale = t.scale; g.fold = t.fold;
    g.out = (void*)(ws + ((t.epi == E_RESID || t.epi == E_RESID0) ? WS_XH : t.o));
    g.st_in = (const float*)(ws + WS_ST) + (size_t)t.st_in * TT * 8; g.st_out = (float*)(ws + WS_ST) + (size_t)t.st_out * TT * 8;
    g.cs = (const float*)(ws + WS_CSBW) + t.cs;
    if (t.rkind == 1) { g.res = P->in[0]; g.bias = nullptr; }
    else if (t.rkind == 2) { g.res = P->in[t.gidx] + t.gl * DM; g.bias = P->in[t.gidx + 1] + t.gl * DM; }
    else { g.res = nullptr; g.bias = (const float*)(ws + (t.bias < 0 ? 0 : t.bias)); }
}

__global__ void __launch_bounds__(512, 2) fwd_megakernel(Params Pval) {
    extern __shared__ __attribute__((aligned(16))) unsigned char lds_raw[];
    LAS unsigned char* lds = (LAS unsigned char*)lds_raw;
    cg::grid_group grid = cg::this_grid();
    volatile LAS unsigned* bst = (volatile LAS unsigned*)(lds + 131072 + 8192 + 1024);
    if (threadIdx.x < 2) bst[threadIdx.x] = 0u;
    XcdBarrier xbar; xbar.bar = nullptr; xbar.x = 0; xbar.st = bst;
    int ti = 0;
    {
        KP P = kparams();
        if (bid_here() == 0) { unsigned* bw = (unsigned*)(P->ws + WS_BAR); for (int i = tid_here(); i < XCD_BAR_WORDS; i += 512) bw[i] = 0u; }
        prologue(lds, P);
        grid.sync();
        xbar = xcd_barrier_post((unsigned*)(P->ws + WS_BAR), bst);
    }
    for (int ph = 1; ph < 28; ++ph) {
        { const int sq = ph < 2 ? -1 : (ph - 2) % 13; if (ph == 2 || sq == 4 || sq == 9 || (sq == 12 && ph != 27)) continue; }
        KP P = kparams();
        {
            const int l = ph < 2 ? 0 : (ph - 2) / 13, s = ph < 2 ? -1 : (ph - 2) % 13;
            if (s == 1) conv_phase(lds, P, l);
            if (s == 2) attn_phase(lds, P);
            if (ph == 1) csbw_finalize(P);
            if (s == 12 && l == 1) ln_final(P, P->in[23] + DM, P->in[24] + DM);
            for (; GTAB[ti].ph == ph; ++ti) {
              {
                GemmDesc g; load_gemm(g, ti, P);
                unsigned char* ws = P->ws;
                __syncthreads();
                switch (g.epi) {
                case E_INPROJ: gemm_run<E_INPROJ>(lds, g, ws); break;
                case E_QUP: gemm_run<E_QUP>(lds, g, ws); break;
                case E_KUP: gemm_run<E_KUP>(lds, g, ws); break;
                case E_VTUP: gemm_run<E_VTUP>(lds, g, ws); break;
                case E_F16: gemm_run<E_F16>(lds, g, ws); break;
                case E_RESID: gemm_run<E_RESID>(lds, g, ws); break;
                case E_RESID0: gemm_run<E_RESID0>(lds, g, ws); break;
                case E_SOFTMAX: gemm_run<E_SOFTMAX>(lds, g, ws); break;
                default: gemm_run<E_SWIGLU>(lds, g, ws); break;
                }
                __syncthreads();
              }
            }
        }
        if (ph != 27) xcd_barrier(xbar);
    }
}

extern "C" void kernel_launch(void* const* d_in, const int* in_sizes, int n_in, void* d_out, int out_size, void* d_ws, size_t ws_size, hipStream_t stream) {
    static int grid_blocks = 0;
    if (!grid_blocks) {
        if (n_in != 25 || ws_size < WS_END) { fprintf(stderr, "kernel_launch: unexpected n_in %d / ws_size %zu\n", n_in, ws_size); grid_blocks = -1; return; }
        int dev = 0, cus = 0, per_cu = 0;
        hipGetDevice(&dev);
        hipDeviceGetAttribute(&cus, hipDeviceAttributeMultiprocessorCount, dev);
        if (hipFuncSetAttribute((const void*)fwd_megakernel, hipFuncAttributeMaxDynamicSharedMemorySize, LDS_BYTES) != hipSuccess) fprintf(stderr, "kernel_launch: hipFuncSetAttribute failed\n");
        hipOccupancyMaxActiveBlocksPerMultiprocessor(&per_cu, (const void*)fwd_megakernel, 512, LDS_BYTES);
        if (per_cu < 1) { fprintf(stderr, "kernel_launch: occupancy query gave %d\n", per_cu); per_cu = 1; }
        grid_blocks = cus * 1;
        (void)hipGetLastError();
    }
    if (grid_blocks < 0) return;
    Params p{};
    for (int i = 0; i < 25; ++i) p.in[i] = (const float*)d_in[i];
    p.pos = (const int*)d_in[2];
    p.out = (float*)d_out; p.ws = (unsigned char*)d_ws;
    void* args[] = {&p};
    hipError_t e = hipLaunchCooperativeKernel((const void*)fwd_megakernel, dim3(grid_blocks), dim3(512), args, LDS_BYTES, stream);
    if (e != hipSuccess) fprintf(stderr, "cooperative launch failed: %s (grid %d)\n", hipGetErrorString(e), grid_blocks);
}
```

```cpp
#include <hip/hip_runtime.h>
#include <hip/hip_cooperative_groups.h>
#include <cstdio>
#include <cstdint>
namespace cg = cooperative_groups;

#define LAS __attribute__((address_space(3)))
typedef _Float16 h16;
typedef _Float16 h16x8 __attribute__((ext_vector_type(8)));
typedef _Float16 h16x4 __attribute__((ext_vector_type(4)));
typedef _Float16 h16x2 __attribute__((ext_vector_type(2)));
typedef float f32x4 __attribute__((ext_vector_type(4)));
typedef float f32x2 __attribute__((ext_vector_type(2)));
typedef float f32x16 __attribute__((ext_vector_type(16)));
typedef unsigned u32x4 __attribute__((ext_vector_type(4)));

constexpr int TT = 65536, DM = 1024, SEQ = 2048, NB = 32, MEMT = 8192, FFH = 2816;
constexpr int PROJW = 1536;
constexpr float ALPHA = 1.4142135623730951f;
constexpr float QSCALE = 0.14724444602590306f;
constexpr float XQSCALE = 0.09016844005556021f;
constexpr size_t MiB = 1u << 20;
constexpr size_t WS_BIAS = 0;
constexpr size_t WS_W = 1 * MiB;
constexpr size_t WS_COS = 65 * MiB, WS_SIN = 69 * MiB, WS_SSQ = 73 * MiB;
constexpr size_t WS_MEMH = 76 * MiB, WS_XK = 92 * MiB, WS_XVT = 124 * MiB;
constexpr size_t WS_XH = 156 * MiB, WS_YCAT = 284 * MiB, WS_VT = 412 * MiB, WS_KR = 476 * MiB, WS_BIG = 480 * MiB;
constexpr size_t WS_PROJ = WS_BIG, WS_Q = WS_BIG + 224 * MiB, WS_KN = WS_BIG + 320 * MiB;
constexpr size_t WS_XQ = WS_BIG, WS_P = WS_BIG + 128 * MiB, WS_XO = WS_BIG + 256 * MiB, WS_H = WS_BIG;
constexpr size_t WS_PART = 864 * MiB;
constexpr size_t WS_CSBW = 867 * MiB;
constexpr size_t WS_ST = 868 * MiB;
constexpr size_t WS_END = 872 * MiB;
constexpr int NCS = 1792 + 1024 + 5632;
constexpr size_t WO_WIN = 0, WO_WUQ = WO_WIN + 1792 * 1024, WO_WUK = WO_WUQ + 768 * 256, WO_WUV = WO_WUK + 512 * 256,
                 WO_WO = WO_WUV + 512 * 256, WO_XWQ = WO_WO + 1024 * 1024, WO_XWKV = WO_XWQ + 1024 * 1024,
                 WO_XWO = WO_XWKV + 2048 * 1024, WO_FWIN = WO_XWO + 1024 * 1024, WO_FWD = WO_FWIN + 5632 * 1024,
                 WO_END = WO_FWD + 1024 * 2816;
static_assert(WO_END * 2 <= 32 * MiB, "weights per layer");
constexpr int LDS_STATS = 131072 + 8192 + 1024 + 64;
constexpr int LDS_COLS = LDS_STATS + 2 * 8192;
constexpr int LDS_BYTES = LDS_COLS + 2 * 2048;
constexpr size_t WS_BAR = 256 * 1024;

struct Params {
    const float* in[25];
    const int* pos;
    float* out;
    unsigned char* ws;
};

typedef const __attribute__((address_space(4))) Params* KP;
__device__ __forceinline__ KP kparams() { KP p = (KP)__builtin_amdgcn_kernarg_segment_ptr(); asm volatile("" : "+s"(p)); return p; }

__device__ __forceinline__ int tid_here() { int t = threadIdx.x; asm volatile("" : "+v"(t)); return t; }
__device__ __forceinline__ int bid_here() { int b = blockIdx.x; asm volatile("" : "+s"(b)); return b; }

__device__ __forceinline__ float wave_sum(float v) {
#pragma unroll
    for (int o = 1; o < 64; o <<= 1) v += __shfl_xor(v, o);
    return v;
}
__device__ __forceinline__ h16x4 cvt4(f32x4 v) { h16x4 r; r[0] = (h16)v[0]; r[1] = (h16)v[1]; r[2] = (h16)v[2]; r[3] = (h16)v[3]; return r; }
__device__ __forceinline__ float fast_exp2(float x) { return __builtin_amdgcn_exp2f(x); }

constexpr int BM = 256, BK = 64, HALF = 128, HTB = HALF * BK * 2, NXCD = 8, WGM = 8;
__device__ __forceinline__ int lds_byte(int r, int c) { const int st = (r >> 4) * 2 + (c >> 5), rr = r & 15, cc = c & 31, ob = rr * 64 + cc * 2; return st * 1024 + (ob ^ (((ob >> 9) & 1) << 5)); }
__device__ __forceinline__ void stage_rc(int b, int& R, int& C) { const int st = b / 1024, sb = b % 1024, swz = sb ^ (((sb >> 9) & 1) << 5); R = (st >> 1) * 16 + swz / 64; C = (st & 1) * 32 + (swz % 64) / 2; }

__device__ __forceinline__ int perm32(int rho) { const int n = rho >> 4, i = rho & 15; return 8 * (i >> 2) + 4 * n + (i & 3); }
enum { E_INPROJ = 0, E_QUP, E_KUP, E_VTUP, E_F16, E_RESID, E_SOFTMAX, E_SWIGLU, E_RESID0 };
struct GemmDesc {
    const h16* A; const h16* B; int lda, ldb, K;
    int nM, nN, nZ1, nZ2;
    int a_s1, a_s2, b_s1, b_s2;
    int epi;
    void* out; int ldc; float scale; const float* res; const float* bias;
    const float* st_in; float* st_out; const float* cs; int fold;
};
struct Unit { int row0, col0, pn; unsigned a, b; };

__device__ __forceinline__ bool unit_next(const GemmDesc& g, int i, int G, int c, Unit& u) {
    const int nwg = g.nZ1 * g.nZ2 * g.nM * g.nN;
    const long L = (long)i * G + c; if (L >= nwg) return false;
    int zb = 0, zh = 0, pm, pn;
    if (g.nZ1 * g.nZ2 == 1) {
        const int nM = g.nM, nN = g.nN;
        int wgid = (int)L; { const int q = nwg / NXCD, r = nwg % NXCD, xcd = wgid % NXCD, off = wgid / NXCD; wgid = (xcd < r ? xcd * (q + 1) : r * (q + 1) + (xcd - r) * q) + off; }
        const int nig = WGM * nN, gid = wgid / nig, fm = gid * WGM, gsz = (nM - fm) < WGM ? (nM - fm) : WGM;
        pm = fm + ((wgid % nig) % gsz); pn = (wgid % nig) / gsz;
    } else {
        int r = (int)L; pn = r % g.nN; r /= g.nN; pm = r % g.nM; r /= g.nM; zh = r % g.nZ2; zb = r / g.nZ2;
    }
    u.row0 = (zb * g.nM + pm) * BM; u.col0 = (zh * g.nN + pn) * BM; u.pn = pn;
    u.a = (unsigned)(zb * g.a_s1 + zh * g.a_s2 + pm * BM * g.lda) * 2u;
    u.b = (unsigned)(zb * g.b_s1 + zh * g.b_s2 + pn * BM * g.ldb) * 2u;
    return true;
}

__device__ __forceinline__ void row_stats(const LAS float* st, int row, float& mu, float& rstd) {
    const f32x4 a = *(const LAS f32x4*)(st + row * 8), b = *(const LAS f32x4*)(st + row * 8 + 4);
    mu = ((a[0] + a[2]) + (b[0] + b[2])) * (1.f / DM);
    const float var = ((a[1] + a[3]) + (b[1] + b[3])) * (1.f / DM) - mu * mu;
    rstd = __builtin_amdgcn_rsqf(var + 1e-5f);
}
template <int CN> __device__ __forceinline__ void fold_acc(f32x4 (&acc)[2][2][4][2], const LAS float* stl, const LAS float* ctl, int rloc, int cloc) {
    f32x4 cs[2][2], bw[2][2];
#pragma unroll
    for (int bj = 0; bj < 2; ++bj)
#pragma unroll
        for (int n = 0; n < 2; ++n) { cs[bj][n] = *(const LAS f32x4*)(ctl + cloc + bj * HALF + n * CN); bw[bj][n] = *(const LAS f32x4*)(ctl + 256 + cloc + bj * HALF + n * CN); }
#pragma unroll
    for (int ai = 0; ai < 2; ++ai)
#pragma unroll
        for (int m = 0; m < 4; ++m) { float mu, rstd; row_stats(stl, rloc + ai * HALF + m * 16, mu, rstd);
#pragma unroll
            for (int bj = 0; bj < 2; ++bj)
#pragma unroll
                for (int n = 0; n < 2; ++n) acc[ai][bj][m][n] = (acc[ai][bj][m][n] - cs[bj][n] * mu) * rstd + bw[bj][n]; }
}

#define LDS_BARRIER() asm volatile("s_waitcnt lgkmcnt(0)\n\ts_barrier" ::: "memory")
template <int EPI> __device__ __forceinline__ void epilogue(const GemmDesc& g, const Unit& u, f32x4 (&acc)[2][2][4][2], int wr, int wc, int fr, int fq,
                                         LAS unsigned char* lds, unsigned char* ws, const LAS float* stl, const LAS float* ctl) {
    const float* COS = (const float*)(ws + WS_COS); const float* SIN = (const float*)(ws + WS_SIN); float* SSQ = (float*)(ws + WS_SSQ);
    const int rbase = u.row0 + wr * 64 + fr;
    constexpr int CN = 4;
    const int cbase = u.col0 + wc * 32 + 8 * fq;
    if (EPI == E_INPROJ || EPI == E_F16 || EPI == E_SWIGLU) { if (g.fold) fold_acc<CN>(acc, stl, ctl, wr * 64 + fr, cbase - u.col0); }
    switch (EPI) {
    case E_INPROJ: {
        if (u.pn < 6) {
            h16* O = (h16*)g.out;
            f32x4 bv[2][2];
#pragma unroll
            for (int bj = 0; bj < 2; ++bj)
#pragma unroll
                for (int n = 0; n < 2; ++n) bv[bj][n] = *(const f32x4*)(g.bias + cbase + bj * HALF + n * CN);
#pragma unroll
            for (int ai = 0; ai < 2; ++ai)
#pragma unroll
                for (int m = 0; m < 4; ++m) {
                    const int row = rbase + ai * HALF + m * 16; float ss = 0.f;
#pragma unroll
                    for (int bj = 0; bj < 2; ++bj)
#pragma unroll
                        for (int n = 0; n < 2; ++n) { const f32x4 v = acc[ai][bj][m][n] + bv[bj][n]; ss += (v[0] * v[0] + v[1] * v[1]) + (v[2] * v[2] + v[3] * v[3]);
                            *(h16x4*)(O + (size_t)row * PROJW + cbase + bj * HALF + n * CN) = cvt4(v); }
                    if (u.pn < 2) { ss += __shfl_xor(ss, 16); ss += __shfl_xor(ss, 32); if (fq == 0) SSQ[(size_t)row * 8 + u.pn * 4 + wc] = ss; }
                }
        } else if (wc == 0) {
            h16* KR = (h16*)(ws + WS_KR);
            const f32x4 b0 = *(const f32x4*)(g.bias + 1536 + 4 * fq), b1 = *(const f32x4*)(g.bias + 1536 + 16 + 4 * fq);
#pragma unroll
            for (int ai = 0; ai < 2; ++ai)
#pragma unroll
                for (int m = 0; m < 4; ++m) {
                    const int row = rbase + ai * HALF + m * 16;
                    const f32x4 c = *(const f32x4*)(COS + (size_t)row * 16 + 4 * fq), s = *(const f32x4*)(SIN + (size_t)row * 16 + 4 * fq);
                    const f32x4 v0 = acc[ai][0][m][0] + b0, v1 = acc[ai][0][m][1] + b1;
                    *(h16x4*)(KR + (size_t)row * 32 + 4 * fq) = cvt4(v0 * c - v1 * s);
                    *(h16x4*)(KR + (size_t)row * 32 + 16 + 4 * fq) = cvt4(v0 * s + v1 * c);
                }
        }
    } break;
    case E_QUP: {
        h16* O = (h16*)g.out;
#pragma unroll
        for (int ai = 0; ai < 2; ++ai) {
            float scr_[4]; f32x4 cr[4], sr[4];
#pragma unroll
            for (int m = 0; m < 4; ++m) { const int row = rbase + ai * HALF + m * 16;
                const f32x4 q4 = *(const LAS f32x4*)(stl + (row - u.row0) * 8);
                scr_[m] = QSCALE * __builtin_amdgcn_rsqf(((q4[0] + q4[1]) + (q4[2] + q4[3])) * (1.f / 256.f) + 1e-6f);
                cr[m] = *(const f32x4*)(COS + (size_t)row * 16 + 4 * fq); sr[m] = *(const f32x4*)(SIN + (size_t)row * 16 + 4 * fq); }
#pragma unroll
            for (int m = 0; m < 4; ++m) {
                const int row = rbase + ai * HALF + m * 16;
                const float sc = scr_[m]; const f32x4 c = cr[m], s = sr[m];
#pragma unroll
                for (int bj = 0; bj < 2; ++bj) {
                    const int gcol = u.col0 + bj * HALF + wc * 32;
                    const f32x4 v0 = acc[ai][bj][m][0] * sc, v1 = acc[ai][bj][m][1] * sc;
                    if ((gcol >> 5) % 3 == 2) {
                        *(h16x4*)(O + (size_t)row * 768 + gcol + 4 * fq) = cvt4(v0 * c - v1 * s);
                        *(h16x4*)(O + (size_t)row * 768 + gcol + 16 + 4 * fq) = cvt4(v0 * s + v1 * c);
                    } else {
                        *(h16x4*)(O + (size_t)row * 768 + gcol + 8 * fq) = cvt4(v0);
                        *(h16x4*)(O + (size_t)row * 768 + gcol + 8 * fq + 4) = cvt4(v1);
                    }
                }
            }
        }
    } break;
    case E_KUP: {
        h16* O = (h16*)g.out;
        float scr_[2][4];
#pragma unroll
        for (int ai = 0; ai < 2; ++ai)
#pragma unroll
            for (int m = 0; m < 4; ++m) { const f32x4 q4 = *(const LAS f32x4*)(stl + (rbase - u.row0 + ai * HALF + m * 16) * 8 + 4);
                scr_[ai][m] = __builtin_amdgcn_rsqf(((q4[0] + q4[1]) + (q4[2] + q4[3])) * (1.f / 256.f) + 1e-6f); }
#pragma unroll
        for (int ai = 0; ai < 2; ++ai)
#pragma unroll
            for (int m = 0; m < 4; ++m) {
                const int row = rbase + ai * HALF + m * 16; const float sc = scr_[ai][m];
#pragma unroll
                for (int bj = 0; bj < 2; ++bj)
#pragma unroll
                    for (int n = 0; n < 2; ++n) *(h16x4*)(O + (size_t)row * 512 + cbase + bj * HALF + n * CN) = cvt4(acc[ai][bj][m][n] * sc);
            }
    } break;
    case E_VTUP: {
        h16* O = (h16*)g.out;
        f32x4 sc[2][2];
#pragma unroll
        for (int bj = 0; bj < 2; ++bj)
#pragma unroll
            for (int n = 0; n < 2; ++n)
#pragma unroll
                for (int j = 0; j < 4; ++j) { const f32x4 q4 = *(const LAS f32x4*)(stl + (cbase - u.col0 + bj * HALF + n * CN + j) * 8 + 4);
                    sc[bj][n][j] = __builtin_amdgcn_rsqf(((q4[0] + q4[1]) + (q4[2] + q4[3])) * (1.f / 256.f) + 1e-6f); }
#pragma unroll
        for (int ai = 0; ai < 2; ++ai)
#pragma unroll
            for (int m = 0; m < 4; ++m) {
                const int row = rbase + ai * HALF + m * 16;
#pragma unroll
                for (int bj = 0; bj < 2; ++bj)
#pragma unroll
                    for (int n = 0; n < 2; ++n) *(h16x4*)(O + (size_t)row * TT + cbase + bj * HALF + n * CN) = cvt4(acc[ai][bj][m][n] * sc[bj][n]);
            }
    } break;
    case E_F16: {
        h16* O = (h16*)g.out; const float sc = g.scale; const int ldc = g.ldc;
#pragma unroll
        for (int ai = 0; ai < 2; ++ai)
#pragma unroll
            for (int m = 0; m < 4; ++m) {
                const int row = rbase + ai * HALF + m * 16;
#pragma unroll
                for (int bj = 0; bj < 2; ++bj)
#pragma unroll
                    for (int n = 0; n < 2; ++n) *(h16x4*)(O + (size_t)row * ldc + cbase + bj * HALF + n * CN) = cvt4(acc[ai][bj][m][n] * sc);
            }
    } break;
    case E_RESID0:
    case E_RESID: {
        constexpr bool FOLD = (EPI == E_RESID);
        const h16* ZH = (const h16*)(ws + WS_XH); h16* ZO = (h16*)g.out;
        LAS f32x2* PP = (LAS f32x2*)(lds + 131072);
#define RS_LOAD(ZB, XB, ai_, m0_) do { _Pragma("unroll") for (int mm = 0; mm < 2; ++mm) { const size_t off_ = (size_t)(rbase + (ai_) * HALF + ((m0_) + mm) * 16) * DM + cbase; \
            _Pragma("unroll") for (int bj = 0; bj < 2; ++bj) { if (FOLD) ZB[mm][bj] = *(const h16x8*)(ZH + off_ + bj * HALF); \
                else { XB[mm][bj][0] = *(const f32x4*)(g.res + off_ + bj * HALF); XB[mm][bj][1] = *(const f32x4*)(g.res + off_ + bj * HALF + 4); } } } } while (0)
#define RS_PROC(ZB, XB, ai_, m0_) do { _Pragma("unroll") for (int mm = 0; mm < 2; ++mm) { const int m = (m0_) + mm; \
            const int row = rbase + (ai_) * HALF + m * 16; const size_t off = (size_t)row * DM + cbase; \
            float mu_ = 0.f, rstd_ = 1.f; if (FOLD) row_stats(stl, row - u.row0, mu_, rstd_); \
            const LAS float* ctr = ctl + (cbase - u.col0); asm volatile("" : "+v"(ctr)); \
            float ps = 0.f, pss = 0.f; \
            _Pragma("unroll") for (int bj = 0; bj < 2; ++bj) { h16x8 zo; \
                _Pragma("unroll") for (int n = 0; n < 2; ++n) { f32x4 x; \
                    if (FOLD) { const f32x4 gvv = *(const LAS f32x4*)(ctr + bj * HALF + n * CN), bvv = *(const LAS f32x4*)(ctr + 256 + bj * HALF + n * CN); \
                        _Pragma("unroll") for (int j = 0; j < 4; ++j) x[j] = ((float)ZB[mm][bj][4 * n + j] - mu_) * rstd_ * gvv[j] + bvv[j]; } \
                    else x = XB[mm][bj][n]; \
                    const f32x4 z = x * ALPHA + acc[ai_][bj][m][n]; \
                    ps += (z[0] + z[1]) + (z[2] + z[3]); pss += (z[0] * z[0] + z[1] * z[1]) + (z[2] * z[2] + z[3] * z[3]); \
                    _Pragma("unroll") for (int j = 0; j < 4; ++j) zo[4 * n + j] = (h16)z[j]; } \
                *(h16x8*)(ZO + off + bj * HALF) = zo; } \
            ps += __shfl_xor(ps, 16); ps += __shfl_xor(ps, 32); pss += __shfl_xor(pss, 16); pss += __shfl_xor(pss, 32); \
            if (fq == 0) PP[((ai_) * HALF + wr * 64 + m * 16 + fr) * 4 + wc] = (f32x2){ps, pss}; } } while (0)
        if (FOLD) {
            h16x8 zA[2][2], zB[2][2]; f32x4 xd[2][2][2];
            RS_LOAD(zA, xd, 0, 0); RS_LOAD(zB, xd, 0, 2);
            RS_PROC(zA, xd, 0, 0); RS_LOAD(zA, xd, 1, 0);
            RS_PROC(zB, xd, 0, 2); RS_LOAD(zB, xd, 1, 2);
            RS_PROC(zA, xd, 1, 0);
            RS_PROC(zB, xd, 1, 2);
        } else {
            h16x8 zd[2][2]; f32x4 xA[2][2][2];
#pragma unroll
            for (int ai = 0; ai < 2; ++ai)
#pragma unroll
                for (int m0 = 0; m0 < 4; m0 += 2) { RS_LOAD(zd, xA, ai, m0); RS_PROC(zd, xA, ai, m0); }
        }
#undef RS_LOAD
#undef RS_PROC
        LDS_BARRIER();
        { const int t = wr * 256 + wc * 64 + fq * 16 + fr;
          if (t < 256) { const f32x2 a = PP[t * 4 + 0], b = PP[t * 4 + 1], c = PP[t * 4 + 2], d = PP[t * 4 + 3];
              *(f32x2*)(g.st_out + (size_t)(u.row0 + t) * 8 + u.pn * 2) = (f32x2){(a[0] + b[0]) + (c[0] + d[0]), (a[1] + b[1]) + (c[1] + d[1])}; } }
    } break;
    case E_SOFTMAX: {
        h16* O = (h16*)g.out;
        LAS float* PM = (LAS float*)(lds + 131072);
        LAS float* PS = (LAS float*)(lds + 131072 + 4096);
        float mx[2][4];
#pragma unroll
        for (int ai = 0; ai < 2; ++ai)
#pragma unroll
            for (int m = 0; m < 4; ++m) {
                float v = -INFINITY;
#pragma unroll
                for (int bj = 0; bj < 2; ++bj)
#pragma unroll
                    for (int n = 0; n < 2; ++n) { const f32x4 x = acc[ai][bj][m][n]; v = fmaxf(v, fmaxf(fmaxf(x[0], x[1]), fmaxf(x[2], x[3]))); }
                v = fmaxf(v, __shfl_xor(v, 16)); v = fmaxf(v, __shfl_xor(v, 32));
                if (fq == 0) PM[(ai * HALF + wr * 64 + m * 16 + fr) * 4 + wc] = v;
            }
        LDS_BARRIER();
#pragma unroll
        for (int ai = 0; ai < 2; ++ai)
#pragma unroll
            for (int m = 0; m < 4; ++m) {
                const f32x4 p = *(const LAS f32x4*)(PM + (ai * HALF + wr * 64 + m * 16 + fr) * 4);
                const float mm = fmaxf(fmaxf(p[0], p[1]), fmaxf(p[2], p[3])); mx[ai][m] = mm; float s = 0.f;
#pragma unroll
                for (int bj = 0; bj < 2; ++bj)
#pragma unroll
                    for (int n = 0; n < 2; ++n) { f32x4 x = acc[ai][bj][m][n];
#pragma unroll
                        for (int j = 0; j < 4; ++j) { x[j] = fast_exp2(x[j] - mm); s += x[j]; }
                        acc[ai][bj][m][n] = x; }
                s += __shfl_xor(s, 16); s += __shfl_xor(s, 32);
                if (fq == 0) PS[(ai * HALF + wr * 64 + m * 16 + fr) * 4 + wc] = s;
            }
        LDS_BARRIER();
#pragma unroll
        for (int ai = 0; ai < 2; ++ai)
#pragma unroll
            for (int m = 0; m < 4; ++m) {
                const f32x4 p = *(const LAS f32x4*)(PS + (ai * HALF + wr * 64 + m * 16 + fr) * 4);
                const float inv = 1.f / ((p[0] + p[1]) + (p[2] + p[3]));
                const int row = rbase + ai * HALF + m * 16;
#pragma unroll
                for (int bj = 0; bj < 2; ++bj)
#pragma unroll
                    for (int n = 0; n < 2; ++n) *(h16x4*)(O + (size_t)row * DM + cbase + bj * HALF + n * CN) = cvt4(acc[ai][bj][m][n] * inv);
            }
        (void)mx;
    } break;
    case E_SWIGLU: {
        h16* O = (h16*)g.out;
#pragma unroll
        for (int ai = 0; ai < 2; ++ai)
#pragma unroll
            for (int m = 0; m < 4; ++m) {
                const int row = rbase + ai * HALF + m * 16;
#pragma unroll
                for (int n = 0; n < 2; ++n) { const f32x4 gt = acc[ai][0][m][n], up = acc[ai][1][m][n]; f32x4 hv;
#pragma unroll
                    for (int j = 0; j < 4; ++j) hv[j] = gt[j] * __builtin_amdgcn_rcpf(1.f + fast_exp2(gt[j] * -1.4426950408889634f)) * up[j];
                    *(h16x4*)(O + (size_t)row * FFH + u.pn * HALF + (cbase - u.col0) + n * CN) = cvt4(hv); }
            }
    } break;
    default: break;
    }
}

template <int EPI> __device__ __forceinline__ void gemm_run(LAS unsigned char* lds, const GemmDesc& g, unsigned char* ws) {
    const int tid = tid_here(), wid = __builtin_amdgcn_readfirstlane(tid >> 6), lane = tid & 63, wr = wid >> 2, wc = wid & 3, fr = lane & 15, fq = lane >> 4;
    LAS int* utab = (LAS int*)(lds + 131072 + 8192);
    if (tid < 32) { Unit u; const bool ok = unit_next(g, tid, gridDim.x, bid_here(), u);
        utab[tid * 8 + 0] = ok ? u.row0 : -1; utab[tid * 8 + 1] = u.col0; utab[tid * 8 + 2] = u.pn; utab[tid * 8 + 3] = (int)u.a; utab[tid * 8 + 4] = (int)u.b; }
    __syncthreads();
#define UT(i, f) __builtin_amdgcn_readfirstlane(utab[(i) * 8 + (f)])
    const int nt = g.K / BK;
    const char* const gA = (const char*)g.A; const char* const gB = (const char*)g.B;
    unsigned voffA[2], voffB[2];
#pragma unroll
    for (int i = 0; i < 2; ++i) { int R, C; stage_rc(tid * 16 + i * 8192, R, C); const int Rb = (R & ~31) + perm32(R & 31);
        voffA[i] = (unsigned)(R * g.lda + C) * 2u; voffB[i] = (unsigned)(Rb * g.ldb + C) * 2u; }
    const unsigned kstep = (unsigned)(BK * 2);
    const unsigned hstepA = (unsigned)HALF * g.lda * 2u, hstepB = (unsigned)HALF * g.ldb * 2u;
    const unsigned ldsw = (unsigned)wid * 1024u;
    const int aoff = lds_byte(wr * 64 + fr, fq * 8), boff = lds_byte(wc * 32 + fr, fq * 8);
#define SA(b, h) (((b) * 2 + (h)) * HTB)
#define SB(b, h) ((4 + (b) * 2 + (h)) * HTB)
#define STAGE(bufoff, gbase, soff, voff) do { _Pragma("unroll") for (int _i = 0; _i < 2; ++_i) \
        __builtin_amdgcn_global_load_lds((const unsigned*)((gbase) + (size_t)((soff) + (voff)[_i])), (LAS unsigned*)(lds + (bufoff) + ldsw + _i * 8192), 16, 0, 0); } while (0)
#define LDA(dst, b, h) do { _Pragma("unroll") for (int m = 0; m < 4; ++m) _Pragma("unroll") for (int k = 0; k < 2; ++k) dst[m][k] = *(const LAS h16x8*)(lds + SA(b, h) + aoff + m * 2048 + k * 1024); } while (0)
#define LDB(dst, b, h) do { _Pragma("unroll") for (int n = 0; n < 2; ++n) _Pragma("unroll") for (int k = 0; k < 2; ++k) dst[n][k] = *(const LAS h16x8*)(lds + SB(b, h) + boff + n * 2048 + k * 1024); } while (0)
#define MMA(ai, bj, At, Bt) do { __builtin_amdgcn_s_setprio(1); _Pragma("unroll") for (int m = 0; m < 4; ++m) _Pragma("unroll") for (int n = 0; n < 2; ++n) _Pragma("unroll") for (int k = 0; k < 2; ++k) \
        acc[ai][bj][m][n] = __builtin_amdgcn_mfma_f32_16x16x32_f16(Bt[n][k], At[m][k], acc[ai][bj][m][n], 0, 0, 0); __builtin_amdgcn_s_setprio(0); } while (0)
#define MMAZ(ai, bj, At, Bt) do { __builtin_amdgcn_s_setprio(1); _Pragma("unroll") for (int m = 0; m < 4; ++m) _Pragma("unroll") for (int n = 0; n < 2; ++n) { \
        acc[ai][bj][m][n] = __builtin_amdgcn_mfma_f32_16x16x32_f16(Bt[n][0], At[m][0], (f32x4){0.f, 0.f, 0.f, 0.f}, 0, 0, 0); \
        acc[ai][bj][m][n] = __builtin_amdgcn_mfma_f32_16x16x32_f16(Bt[n][1], At[m][1], acc[ai][bj][m][n], 0, 0, 0); } __builtin_amdgcn_s_setprio(0); } while (0)
#define WAIT_V(n) asm volatile("s_waitcnt vmcnt(" #n ")" ::: "memory")
#define WAIT_L(n) asm volatile("s_waitcnt lgkmcnt(" #n ")" ::: "memory")
#define BAR __builtin_amdgcn_s_barrier()
#define SCHED __builtin_amdgcn_sched_barrier(0)
    Unit cur; int ui = 0;
    cur.row0 = UT(0, 0);
    if (cur.row0 < 0) return;
    cur.col0 = UT(0, 1); cur.pn = UT(0, 2); cur.a = (unsigned)UT(0, 3); cur.b = (unsigned)UT(0, 4);
    f32x4 acc[2][2][4][2];
    h16x8 At[4][2], B0[2][2], B1[2][2];
    unsigned cA = cur.a, cB = cur.b;
    const bool use_ct = (EPI == E_RESID) || ((EPI == E_INPROJ || EPI == E_F16 || EPI == E_SWIGLU) && g.fold);
    const bool use_st = use_ct || EPI == E_QUP || EPI == E_KUP || EPI == E_VTUP;
    const float* const stsrc = (EPI == E_QUP || EPI == E_KUP || EPI == E_VTUP) ? (const float*)(ws + WS_SSQ) : g.st_in;
    const float* const ctA = (EPI == E_RESID) ? g.res : g.cs; const float* const ctB = (EPI == E_RESID) ? g.bias : g.cs + 2 * NCS;
#define STATS_DMA(r0, sel) __builtin_amdgcn_global_load_lds((const unsigned*)(stsrc + (size_t)((r0) + wid * 32 + (lane >> 1)) * 8 + (lane & 1) * 4), (LAS unsigned*)(lds + LDS_STATS + (sel) * 8192 + wid * 1024), 16, 0, 0)
#define COLS_DMA(c0, sel) __builtin_amdgcn_global_load_lds((const unsigned*)((wid == 0 ? ctA : ctB) + (c0) + lane * 4), (LAS unsigned*)(lds + LDS_COLS + (sel) * 2048 + wid * 1024), 16, 0, 0)
    if (use_st) STATS_DMA((EPI == E_VTUP) ? cur.col0 : cur.row0, 0);
    if (use_ct && wid < 2) COLS_DMA(cur.col0, 0);
    STAGE(SB(0, 0), gB, cB, voffB); STAGE(SB(0, 1), gB, cB + hstepB, voffB); STAGE(SA(0, 0), gA, cA, voffA); STAGE(SA(0, 1), gA, cA + hstepA, voffA);
    if (wr == 1) BAR;
    WAIT_V(2); BAR;
    STAGE(SB(1, 0), gB, cB + kstep, voffB); STAGE(SA(1, 0), gA, cA + kstep, voffA); STAGE(SB(1, 1), gB, cB + hstepB + kstep, voffB);
    WAIT_V(6); BAR;
    for (;;) {
        const int nrow0 = (ui + 1 < 32) ? UT(ui + 1, 0) : -1;
        const bool has_next = nrow0 >= 0;
        const unsigned nA = has_next ? (unsigned)UT(ui + 1, 3) : cA, nB = has_next ? (unsigned)UT(ui + 1, 4) : cB;
        { const int t = 0;
            const bool last = (t == nt - 2);
            const unsigned a1 = cA + (unsigned)(t + 1) * kstep;
            const unsigned a2 = last ? nA : cA + (unsigned)(t + 2) * kstep, b2 = last ? nB : cB + (unsigned)(t + 2) * kstep;
            const unsigned a3 = a2 + kstep, b3 = b2 + kstep;
            LDB(B0, 0, 0); LDB(B1, 0, 1); SCHED; LDA(At, 0, 0); STAGE(SA(1, 1), gA, a1 + hstepA, voffA);
            WAIT_V(8); WAIT_L(0); BAR; MMAZ(0, 0, At, B0); MMAZ(0, 1, At, B1); BAR; SCHED;
            LDA(At, 0, 1); STAGE(SB(0, 0), gB, b2, voffB); STAGE(SB(0, 1), gB, b2 + hstepB, voffB); STAGE(SA(0, 0), gA, a2, voffA);
            WAIT_V(8); WAIT_L(0); BAR; MMAZ(1, 0, At, B0); MMAZ(1, 1, At, B1); BAR; SCHED;
            LDB(B0, 1, 0); LDB(B1, 1, 1); SCHED; LDA(At, 1, 0); STAGE(SA(0, 1), gA, a2 + hstepA, voffA);
            WAIT_V(8); WAIT_L(0); BAR; MMA(0, 0, At, B0); MMA(0, 1, At, B1); BAR; SCHED;
            LDA(At, 1, 1); STAGE(SB(1, 0), gB, b3, voffB); STAGE(SB(1, 1), gB, b3 + hstepB, voffB); STAGE(SA(1, 0), gA, a3, voffA);
            WAIT_V(8); WAIT_L(0); BAR; MMA(1, 0, At, B0); MMA(1, 1, At, B1); BAR; SCHED;
        }
        for (int t = 2; t < nt; t += 2) {
            const bool last = (t == nt - 2);
            const unsigned a1 = cA + (unsigned)(t + 1) * kstep;
            const unsigned a2 = last ? nA : cA + (unsigned)(t + 2) * kstep, b2 = last ? nB : cB + (unsigned)(t + 2) * kstep;
            const unsigned a3 = a2 + kstep, b3 = b2 + kstep;
            LDB(B0, 0, 0); LDB(B1, 0, 1); SCHED; LDA(At, 0, 0); STAGE(SA(1, 1), gA, a1 + hstepA, voffA);
            WAIT_V(8); WAIT_L(0); BAR; MMA(0, 0, At, B0); MMA(0, 1, At, B1); BAR; SCHED;
            LDA(At, 0, 1); STAGE(SB(0, 0), gB, b2, voffB); STAGE(SB(0, 1), gB, b2 + hstepB, voffB); STAGE(SA(0, 0), gA, a2, voffA);
            WAIT_V(8); WAIT_L(0); BAR; MMA(1, 0, At, B0); MMA(1, 1, At, B1); BAR; SCHED;
            LDB(B0, 1, 0); LDB(B1, 1, 1); SCHED; LDA(At, 1, 0); STAGE(SA(0, 1), gA, a2 + hstepA, voffA);
            WAIT_V(8); WAIT_L(0); BAR; MMA(0, 0, At, B0); MMA(0, 1, At, B1); BAR; SCHED;
            LDA(At, 1, 1); STAGE(SB(1, 0), gB, b3, voffB); STAGE(SB(1, 1), gB, b3 + hstepB, voffB); STAGE(SA(1, 0), gA, a3, voffA);
            WAIT_V(8); WAIT_L(0); BAR; MMA(1, 0, At, B0); MMA(1, 1, At, B1); BAR; SCHED;
        }
        if (wr == 0) BAR;
        int fr_e = fr, fq_e = fq; asm volatile("" : "+v"(fr_e), "+v"(fq_e));
        epilogue<EPI>(g, cur, acc, wr, wc, fr_e, fq_e, lds, ws, (const LAS float*)(lds + LDS_STATS + (ui & 1) * 8192), (const LAS float*)(lds + LDS_COLS + (ui & 1) * 2048));
        if (has_next) { if (use_st) STATS_DMA((EPI == E_VTUP) ? UT(ui + 1, 1) : nrow0, (ui + 1) & 1); if (use_ct && wid < 2) COLS_DMA(UT(ui + 1, 1), (ui + 1) & 1); }
        if (!has_next) break;
        ++ui;
        cur.row0 = nrow0; cur.col0 = UT(ui, 1); cur.pn = UT(ui, 2); cur.a = nA; cur.b = nB; cA = nA; cB = nB;
        if (wr == 1) BAR;
    }
    WAIT_V(0);
    BAR;
#undef STATS_DMA
#undef COLS_DMA
#undef UT
#undef SA
#undef SB
#undef STAGE
#undef LDA
#undef LDB
#undef MMA
#undef MMAZ
#undef WAIT_V
#undef WAIT_L
#undef BAR
#undef SCHED
}

__device__ const double INV_FREQ[16] = {1.0, 0.5623413251903491, 0.31622776601683794, 0.1778279410038923, 0.1, 0.05623413251903491, 0.03162277660168379,
    0.01778279410038923, 0.01, 0.005623413251903491, 0.0031622776601683794, 0.0017782794100389228, 0.001, 0.0005623413251903491, 0.00031622776601683794, 0.00017782794100389227};

__device__ __forceinline__ void transpose_item(const float* W, int K, int N, h16* WT, int drow, bool rperm, const float* kscale, const float* kbias, float* part, LAS float* scr, int k0, int n0, int lane) {
    { float wv[32];
#pragma unroll
      for (int i = 0; i < 32; ++i) wv[i] = W[(size_t)(k0 + 2 * i + (lane >> 5)) * N + n0 + (lane & 31)];
#pragma unroll
      for (int i = 0; i < 32; ++i) scr[(2 * i + (lane >> 5)) * 33 + (lane & 31)] = wv[i]; }
    asm volatile("s_waitcnt lgkmcnt(0)" ::: "memory");
    const int c = lane & 7;
    float sc[8];
#pragma unroll
    for (int e = 0; e < 8; ++e) sc[e] = kscale ? kscale[k0 + 8 * c + e] : 1.f;
#pragma unroll
    for (int j = 0; j < 4; ++j) { const int n = (lane >> 3) + 8 * j; const LAS float* s = scr + (8 * c) * 33 + n;
        h16x8 o;
#pragma unroll
        for (int e = 0; e < 8; ++e) o[e] = (h16)(s[e * 33] * sc[e]);
        *(h16x8*)(WT + (size_t)(drow + (rperm ? perm32(n) : n)) * K + k0 + 8 * c) = o; }
    if (part) {
        const float myks = kscale[k0 + lane], mykb = kbias[k0 + lane];
        float a = 0.f, b = 0.f; const int n = lane & 31, kh = (lane >> 5) * 32;
#pragma unroll
        for (int kk = 0; kk < 32; ++kk) { const float w = scr[(kh + kk) * 33 + n];
            a += w * __shfl(myks, kh + kk); b += w * __shfl(mykb, kh + kk); }
        a += __shfl_xor(a, 32); b += __shfl_xor(b, 32);
        if (lane < 32) *(f32x2*)(part + ((size_t)(drow + (rperm ? perm32(lane) : lane)) * 16 + (k0 >> 6)) * 2) = (f32x2){a, b};
    }
    asm volatile("s_waitcnt lgkmcnt(0)" ::: "memory");
}

__device__ __forceinline__ void prologue(LAS unsigned char* lds, KP P) {
    const int tid = tid_here(), lane = tid & 63, wave = tid >> 6, bid = bid_here();
    const int G = gridDim.x, gw = bid * 8 + wave, NGW = G * 8;
    const long gt = (long)bid * 512 + tid, NGT = (long)G * 512;
    LAS float* scr = (LAS float*)(lds + wave * 16384);
    constexpr int NJ = 9;
    const int jK[NJ] = {1024, 256, 256, 1024, 1024, 1024, 1024, 1024, 2816};
    const int jN[NJ] = {1568, 768, 1024, 1024, 1024, 2048, 1024, 5632, 1024};
    const int jin[NJ] = {3, 6, 8, 13, 16, 17, 18, 21, 22};
    const size_t jdst[NJ] = {WO_WIN, WO_WUQ, WO_WUK, WO_WO, WO_XWQ, WO_XWKV, WO_XWO, WO_FWIN, WO_FWD};
    int items_per_layer = 0;
#pragma unroll
    for (int j = 0; j < NJ; ++j) items_per_layer += (jK[j] / 64) * (jN[j] / 32);
    for (int it = gw; it < 2 * items_per_layer; it += NGW) {
        const int l = it / items_per_layer; int r = it % items_per_layer; int j = 0;
#pragma unroll
        for (int jj = 0; jj < NJ - 1; ++jj) { const int cnt = (jK[jj] / 64) * (jN[jj] / 32); if (j == jj && r >= cnt) { r -= cnt; j = jj + 1; } }
        int K = 0, N = 0, ini = 0; size_t dsto = 0;
#pragma unroll
        for (int jj = 0; jj < NJ; ++jj) if (j == jj) { K = jK[jj]; N = jN[jj]; ini = jin[jj]; dsto = jdst[jj]; }
        const int nblk = N / 32, kb = r / nblk, nb = r % nblk, n0 = nb * 32;
        int drow = n0; const float* ks = nullptr; const float* kbs = nullptr; float* part = nullptr; bool rperm = false;
        float* partl = (float*)(P->ws + WS_PART) + (size_t)l * NCS * 32;
        if (j == 0) { drow = n0 < 512 ? n0 : (n0 < 544 ? 1536 + (n0 - 512) : n0 - 32); rperm = (n0 == 512); if (l > 0) { ks = P->in[23] + (l - 1) * DM; kbs = P->in[24] + (l - 1) * DM; part = partl; } }
        else if (j == 4) { ks = P->in[14] + l * DM; kbs = P->in[15] + l * DM; part = partl + (size_t)1792 * 32; }
        else if (j == 1) { ks = P->in[5] + l * 256; rperm = (nb % 3 == 2); }
        else if (j == 2) { const int h = nb >> 2, part = nb & 3; drow = part < 2 ? h * 64 + 32 * part : 512 + h * 64 + 32 * (part - 2); ks = P->in[7] + l * 256; }
        else if (j == 7) { const int jj = n0 < FFH ? n0 : n0 - FFH; drow = (jj >> 7) * 256 + (jj & 127) + (n0 < FFH ? 0 : 128); ks = P->in[19] + l * DM; kbs = P->in[20] + l * DM; part = partl + (size_t)(1792 + 1024) * 32; }
        transpose_item(P->in[ini] + (size_t)l * K * N, K, N, (h16*)(P->ws + WS_W + (size_t)l * 32 * MiB) + dsto, drow, rperm, ks, kbs, part, scr, kb * 64, n0, lane);
    }
    for (long i = gt; i < 2L * 224 * 1024 / 8; i += NGT) { const int l = (int)(i / (224 * 1024 / 8)); const long r = i % (224 * 1024 / 8);
        unsigned zz = 0; asm volatile("" : "+v"(zz));
        *(u32x4*)((h16*)(P->ws + WS_W + (size_t)l * 32 * MiB) + WO_WIN + (size_t)1568 * 1024 + r * 8) = (u32x4){zz, zz, zz, zz}; }
    for (long i = gt; i < 2 * 1792; i += NGT) { const int l = (int)(i / 1792), r = (int)(i % 1792);
        const int src = r < 512 ? r : (r < 1536 ? r + 32 : (r < 1568 ? 512 + (r - 1536) : -1));
        ((float*)(P->ws + WS_BIAS))[i] = src >= 0 ? P->in[4][l * 1568 + src] : 0.f; }
    for (long i = gt; i < (long)TT * 16; i += NGT) { const int tok = (int)(i >> 4), f = (int)(i & 15);
        const double ang = (double)P->pos[tok] * INV_FREQ[f];
        const double kq = __builtin_rint(ang * 0.6366197723675814); const double r = (ang - kq * 1.5707963267948966) - kq * 6.123233995736766e-17;
        const double r2 = r * r;
        const double sn = r * (1.0 + r2 * (-1.0 / 6 + r2 * (1.0 / 120 + r2 * (-1.0 / 5040 + r2 * (1.0 / 362880 + r2 * (-1.0 / 39916800))))));
        const double cs = 1.0 + r2 * (-0.5 + r2 * (1.0 / 24 + r2 * (-1.0 / 720 + r2 * (1.0 / 40320 + r2 * (-1.0 / 3628800 + r2 * (1.0 / 479001600))))));
        const int q = (int)((long long)kq & 3);
        const double c = q == 0 ? cs : (q == 1 ? -sn : (q == 2 ? -cs : sn));
        const double s = q == 0 ? sn : (q == 1 ? cs : (q == 2 ? -sn : -cs));
        ((float*)(P->ws + WS_COS))[i] = (float)c; ((float*)(P->ws + WS_SIN))[i] = (float)s; }
    {
        const long n8x = (long)TT * DM / 8, n8m = (long)MEMT * DM / 8;
        for (int pass = 0; pass < 2; ++pass) {
            const f32x4* src = (const f32x4*)(pass == 0 ? P->in[0] : P->in[1]); h16x8* dst = (h16x8*)(P->ws + (pass == 0 ? WS_XH : WS_MEMH)); const long n8 = pass == 0 ? n8x : n8m;
            for (long i = gt; i < n8; i += 4 * NGT) {
                f32x4 a[4], b[4];
#pragma unroll
                for (int q = 0; q < 4; ++q) { const long ii = i + q * NGT; if (ii < n8) { a[q] = src[2 * ii]; b[q] = src[2 * ii + 1]; } }
#pragma unroll
                for (int q = 0; q < 4; ++q) { const long ii = i + q * NGT; if (ii < n8) { h16x8 o; o[0] = (h16)a[q][0]; o[1] = (h16)a[q][1]; o[2] = (h16)a[q][2]; o[3] = (h16)a[q][3]; o[4] = (h16)b[q][0]; o[5] = (h16)b[q][1]; o[6] = (h16)b[q][2]; o[7] = (h16)b[q][3]; dst[ii] = o; } }
            }
        }
    }
}

__device__ __forceinline__ void csbw_finalize(KP P) {
    const long gt = (long)bid_here() * 512 + tid_here(), NGT = (long)gridDim.x * 512;
    const float* part = (const float*)(P->ws + WS_PART); float* cs = (float*)(P->ws + WS_CSBW);
    for (long i = gt; i < 2L * NCS; i += NGT) { const int c = (int)(i % NCS); float a = 0.f, b = 0.f;
        if (!(c >= 1568 && c < 1792) && !(i < 1792)) {
            const f32x2* p = (const f32x2*)part + i * 16;
#pragma unroll
            for (int k = 0; k < 16; ++k) { const f32x2 v = p[k]; a += v[0]; b += v[1]; } }
        cs[i] = a; cs[2 * NCS + i] = b; }
}
__device__ __forceinline__ void ln_final(KP P, const float* gam, const float* bet) {
    const int tid = tid_here(), lane = tid & 63, wave = tid >> 6;
    const int gw = bid_here() * 8 + wave, NGW = gridDim.x * 8;
    f32x4 gv[4], bv[4];
#pragma unroll
    for (int j = 0; j < 2; ++j) { gv[2 * j] = ((const f32x4*)gam)[128 * j + 2 * lane]; gv[2 * j + 1] = ((const f32x4*)gam)[128 * j + 2 * lane + 1];
                                  bv[2 * j] = ((const f32x4*)bet)[128 * j + 2 * lane]; bv[2 * j + 1] = ((const f32x4*)bet)[128 * j + 2 * lane + 1]; }
    h16x8 z[2][2], zn[2][2];
#define LN_LOAD(dst, r0) do { _Pragma("unroll") for (int r = 0; r < 2; ++r) _Pragma("unroll") for (int j = 0; j < 2; ++j) \
        dst[r][j] = ((const h16x8*)((const h16*)(P->ws + WS_XH) + (size_t)((r0) + r) * DM))[64 * j + lane]; } while (0)
    if (gw * 2 < TT) LN_LOAD(z, gw * 2);
    for (int row0 = gw * 2; row0 < TT; row0 += NGW * 2) {
        const bool more = row0 + NGW * 2 < TT;
        if (more) LN_LOAD(zn, row0 + NGW * 2);
#pragma unroll
        for (int r = 0; r < 2; ++r) {
            f32x4 v[4]; float s = 0.f;
#pragma unroll
            for (int j = 0; j < 2; ++j) { v[2 * j] = (f32x4){(float)z[r][j][0], (float)z[r][j][1], (float)z[r][j][2], (float)z[r][j][3]}; v[2 * j + 1] = (f32x4){(float)z[r][j][4], (float)z[r][j][5], (float)z[r][j][6], (float)z[r][j][7]}; }
#pragma unroll
            for (int j = 0; j < 4; ++j) s += (v[j][0] + v[j][1]) + (v[j][2] + v[j][3]);
            const float mean = wave_sum(s) * (1.f / DM); float s2 = 0.f;
#pragma unroll
            for (int j = 0; j < 4; ++j) { v[j] = v[j] - mean; s2 += (v[j][0] * v[j][0] + v[j][1] * v[j][1]) + (v[j][2] * v[j][2] + v[j][3] * v[j][3]); }
            const float rstd = 1.f / sqrtf(wave_sum(s2) * (1.f / DM) + 1e-5f);
            f32x4* xr = (f32x4*)(P->out + (size_t)(row0 + r) * DM);
#pragma unroll
            for (int j = 0; j < 2; ++j) { xr[128 * j + 2 * lane] = v[2 * j] * rstd * gv[2 * j] + bv[2 * j]; xr[128 * j + 2 * lane + 1] = v[2 * j + 1] * rstd * gv[2 * j + 1] + bv[2 * j + 1]; }
        }
        if (more) {
#pragma unroll
            for (int r = 0; r < 2; ++r)
#pragma unroll
                for (int j = 0; j < 2; ++j) z[r][j] = zn[r][j]; }
    }
#undef LN_LOAD
}

__device__ __forceinline__ void conv_phase(LAS unsigned char* lds, KP P, int l) {
    const int tid = tid_here(), lane = tid & 63, wave = tid >> 6;
    const h16* PROJ = (const h16*)(P->ws + WS_PROJ); h16* YC = (h16*)(P->ws + WS_YCAT);
    LAS unsigned* hp = (LAS unsigned*)lds;
    LAS float* cb = (LAS float*)(lds + 65536);
    h16x2 wE[16], wO[16];
    { float w[31];
#pragma unroll
      for (int j = 0; j < 31; ++j) w[j] = P->in[9][(size_t)l * 31 * 512 + j * 512 + tid];
#pragma unroll
      for (int i = 0; i < 15; ++i) { wE[i] = (h16x2){(h16)w[2 * i], (h16)w[2 * i + 1]}; wO[i + 1] = (h16x2){(h16)w[2 * i + 1], (h16)w[2 * i + 2]}; }
      wE[15] = (h16x2){(h16)w[30], (h16)0.f}; wO[0] = (h16x2){(h16)0.f, (h16)w[0]}; }
    const float bias = P->in[10][l * 512 + tid];
    f32x4 ng[2], nbv[2];
#pragma unroll
    for (int j = 0; j < 2; ++j) { ng[j] = *(const f32x4*)(P->in[11] + l * 512 + lane * 8 + 4 * j); nbv[j] = *(const f32x4*)(P->in[12] + l * 512 + lane * 8 + 4 * j); }
    h16x8 ra0[4], rg0[4], ra1[4], rg1[4];
#define CONV_LOAD(uu) do { const int b_ = (uu) >> 6, t0_ = ((uu) & 63) * 32; \
        _Pragma("unroll") for (int k_ = 0; k_ < 4; ++k_) { const int idx_ = tid + 512 * k_; const int pr_ = idx_ >> 6, c8_ = idx_ & 63, tok_ = t0_ - 30 + 2 * pr_; \
            if (idx_ < 31 * 64 && tok_ >= 0) { const h16* src_ = PROJ + (size_t)(b_ * SEQ + tok_) * PROJW + 512 + c8_ * 8; \
                ra0[k_] = *(const h16x8*)src_; rg0[k_] = *(const h16x8*)(src_ + 512); ra1[k_] = *(const h16x8*)(src_ + PROJW); rg1[k_] = *(const h16x8*)(src_ + PROJW + 512); } } } while (0)
#define CONV_GLU(uu) do { const int t0_ = ((uu) & 63) * 32; \
        _Pragma("unroll") for (int k_ = 0; k_ < 4; ++k_) { const int idx_ = tid + 512 * k_; const int pr_ = idx_ >> 6, c8_ = idx_ & 63, tok_ = t0_ - 30 + 2 * pr_; \
            if (idx_ < 31 * 64) { u32x4 d0_ = {0u, 0u, 0u, 0u}, d1_ = {0u, 0u, 0u, 0u}; \
                if (tok_ >= 0) { \
                    _Pragma("unroll") for (int e = 0; e < 8; ++e) { \
                        const float h0_ = (float)ra0[k_][e] * __builtin_amdgcn_rcpf(1.f + fast_exp2((float)rg0[k_][e] * -1.4426950408889634f)); \
                        const float h1_ = (float)ra1[k_][e] * __builtin_amdgcn_rcpf(1.f + fast_exp2((float)rg1[k_][e] * -1.4426950408889634f)); \
                        const h16x2 pk_ = {(h16)h0_, (h16)h1_}; const unsigned w_ = __builtin_bit_cast(unsigned, pk_); \
                        if (e < 4) d0_[e] = w_; else d1_[e - 4] = w_; } } \
                *(LAS u32x4*)(hp + pr_ * 512 + c8_ * 8) = d0_; *(LAS u32x4*)(hp + pr_ * 512 + c8_ * 8 + 4) = d1_; } } } while (0)
    const int u_first = bid_here();
    if (u_first < TT / 32) { CONV_LOAD(u_first); CONV_GLU(u_first); }
    LDS_BARRIER();
    for (int u = u_first; u < TT / 32; u += gridDim.x) {
        const int b = u >> 6, t0 = (u & 63) * 32;
        const int un = u + gridDim.x; const bool has_next = un < TT / 32;
        if (has_next) CONV_LOAD(un);
        for (int m = 0; m < 16; ++m) {
            float a0 = bias, a1 = bias;
#pragma unroll
            for (int i = 0; i < 16; ++i) { const h16x2 p = __builtin_bit_cast(h16x2, hp[(m + i) * 512 + tid]);
                a0 = __builtin_amdgcn_fdot2(p, wE[i], a0, false); a1 = __builtin_amdgcn_fdot2(p, wO[i], a1, false); }
            cb[(2 * m) * 512 + tid] = a0; cb[(2 * m + 1) * 512 + tid] = a1;
        }
        LDS_BARRIER();
        if (has_next) CONV_GLU(un);
#pragma unroll
        for (int k = 0; k < 4; ++k) {
            const int lt = wave * 4 + k;
            f32x4 v0 = *(const LAS f32x4*)(cb + lt * 512 + lane * 8), v1 = *(const LAS f32x4*)(cb + lt * 512 + lane * 8 + 4);
            const float mean = wave_sum((v0[0] + v0[1]) + (v0[2] + v0[3]) + (v1[0] + v1[1]) + (v1[2] + v1[3])) * (1.f / 512.f);
            v0 = v0 - mean; v1 = v1 - mean;
            const float var = wave_sum((v0[0] * v0[0] + v0[1] * v0[1]) + (v0[2] * v0[2] + v0[3] * v0[3]) + (v1[0] * v1[0] + v1[1] * v1[1]) + (v1[2] * v1[2] + v1[3] * v1[3])) * (1.f / 512.f);
            const float rstd = 1.f / sqrtf(var + 1e-5f);
            v0 = v0 * rstd * ng[0] + nbv[0]; v1 = v1 * rstd * ng[1] + nbv[1];
            h16x8 o;
#pragma unroll
            for (int e = 0; e < 4; ++e) { o[e] = (h16)(v0[e] * __builtin_amdgcn_rcpf(1.f + fast_exp2(v0[e] * -1.4426950408889634f))); o[4 + e] = (h16)(v1[e] * __builtin_amdgcn_rcpf(1.f + fast_exp2(v1[e] * -1.4426950408889634f))); }
            *(h16x8*)(YC + (size_t)(b * SEQ + t0 + lt) * DM + 512 + lane * 8) = o;
        }
        LDS_BARRIER();
    }
#undef CONV_LOAD
#undef CONV_GLU
}

constexpr int KPITCH = 208, VPITCH = 264;
__device__ __forceinline__ void attn_phase(LAS unsigned char* lds, KP P) {
    const int tid = tid_here(), lane = tid & 63, r32 = lane & 31, hi = lane >> 5; const int wid = __builtin_amdgcn_readfirstlane(tid >> 6);
    const h16* Q = (const h16*)(P->ws + WS_Q); const h16* KN = (const h16*)(P->ws + WS_KN); const h16* KR = (const h16*)(P->ws + WS_KR);
    const h16* VT = (const h16*)(P->ws + WS_VT); h16* YC = (h16*)(P->ws + WS_YCAT);
    LAS unsigned char* Kb = lds; LAS unsigned char* Vb = lds + 2 * 128 * KPITCH; LAS unsigned char* Sg = lds + 2 * 128 * KPITCH + 2 * 64 * VPITCH + wid * (32 * 144);
    u32x4 sk[3], sv[2];
#define LOADT(J, rowbase_, h_) do { const size_t kb_ = (rowbase_) + 128 * (J); \
        _Pragma("unroll") for (int i_ = 0; i_ < 3; ++i_) { const int c_ = tid + 512 * i_, kr_ = c_ / 12, kc_ = c_ % 12; \
            sk[i_] = kc_ < 8 ? *(const u32x4*)(KN + (kb_ + kr_) * 512 + (h_) * 64 + kc_ * 8) : *(const u32x4*)(KR + (kb_ + kr_) * 32 + (kc_ - 8) * 8); } \
        _Pragma("unroll") for (int i_ = 0; i_ < 2; ++i_) { const int c_ = tid + 512 * i_; \
            sv[i_] = *(const u32x4*)(VT + (size_t)((h_) * 64 + (c_ >> 4)) * TT + kb_ + (c_ & 15) * 8); } } while (0)
#define STORET(buf) do { \
        _Pragma("unroll") for (int i_ = 0; i_ < 3; ++i_) { const int c_ = tid + 512 * i_, kr_ = c_ / 12, kc_ = c_ % 12; \
            *(LAS u32x4*)(Kb + (buf) * 128 * KPITCH + kr_ * KPITCH + kc_ * 16) = sk[i_]; } \
        _Pragma("unroll") for (int i_ = 0; i_ < 2; ++i_) { const int c_ = tid + 512 * i_; LAS unsigned char* vd_ = Vb + (buf) * 64 * VPITCH + (c_ >> 4) * VPITCH + (c_ & 15) * 16; \
            *(LAS unsigned long long*)vd_ = ((unsigned long long)sv[i_][1] << 32) | sv[i_][0]; \
            *(LAS unsigned long long*)(vd_ + 8) = ((unsigned long long)sv[i_][3] << 32) | sv[i_][2]; } } while (0)
#define LOADQ(dst, u_) do { const int bh_ = (u_) & 255, qb_ = 7 - ((u_) >> 8); \
        const h16* qp_ = Q + ((size_t)(bh_ >> 3) * SEQ + qb_ * 256 + wid * 32 + r32) * 768 + (bh_ & 7) * 96 + 8 * hi; \
        _Pragma("unroll") for (int d0 = 0; d0 < 6; ++d0) dst[d0] = *(const h16x8*)(qp_ + 16 * d0); } while (0)
    h16x8 qf[6];
    const int u_first = bid_here();
    if (u_first < 2048) { LOADQ(qf, u_first); LOADT(0, (size_t)((u_first & 255) >> 3) * SEQ, (u_first & 255) & 7); STORET(0); }
    LDS_BARRIER();
    for (int u = u_first; u < 2048; u += gridDim.x) {
        const int bh = u & 255, qb = 7 - (u >> 8), b = bh >> 3, h = bh & 7;
        const size_t rowbase = (size_t)b * SEQ; const int q0 = qb * 256, NT2 = 2 * qb + 2, my_last = 4 * qb + (wid >> 1);
        const int un = u + gridDim.x; const bool has_next = un < 2048;
        const size_t rowbase_n = (size_t)((un & 255) >> 3) * SEQ; const int h_n = (un & 255) & 7;
        f32x16 o0, o1; float m_run = -INFINITY, lsum = 0.f;
#pragma unroll
        for (int r = 0; r < 16; ++r) { o0[r] = 0.f; o1[r] = 0.f; }
        auto compute = [&](const LAS unsigned char* kbase, const LAS unsigned char* vbase) {
                f32x16 p0, p1;
                const LAS unsigned char* kp = kbase + r32 * KPITCH + hi * 16;
                const LAS unsigned char* vp = vbase + r32 * VPITCH + hi * 8;
                h16x8 kf[12];
#pragma unroll
                for (int d0 = 0; d0 < 6; ++d0) { kf[2 * d0] = *(const LAS h16x8*)(kp + d0 * 32); kf[2 * d0 + 1] = *(const LAS h16x8*)(kp + 32 * KPITCH + d0 * 32); }
                __builtin_amdgcn_sched_barrier(0);
#pragma unroll
                for (int d0 = 0; d0 < 6; ++d0) {
                    if (d0 == 0) { const f32x16 z16 = {0.f, 0.f, 0.f, 0.f, 0.f, 0.f, 0.f, 0.f, 0.f, 0.f, 0.f, 0.f, 0.f, 0.f, 0.f, 0.f};
                        p0 = __builtin_amdgcn_mfma_f32_32x32x16_f16(kf[0], qf[0], z16, 0, 0, 0); p1 = __builtin_amdgcn_mfma_f32_32x32x16_f16(kf[1], qf[0], z16, 0, 0, 0); }
                    else { p0 = __builtin_amdgcn_mfma_f32_32x32x16_f16(kf[2 * d0], qf[d0], p0, 0, 0, 0);
                    p1 = __builtin_amdgcn_mfma_f32_32x32x16_f16(kf[2 * d0 + 1], qf[d0], p1, 0, 0, 0); }
                }
                h16x4 vf[4][4];
#pragma unroll
                for (int t = 0; t < 4; ++t) { const int kbyte = (32 * (t >> 1) + 16 * (t & 1)) * 2;
                    vf[t][0] = *(const LAS h16x4*)(vp + kbyte); vf[t][1] = *(const LAS h16x4*)(vp + kbyte + 16);
                    vf[t][2] = *(const LAS h16x4*)(vp + 32 * VPITCH + kbyte); vf[t][3] = *(const LAS h16x4*)(vp + 32 * VPITCH + kbyte + 16); }
                __builtin_amdgcn_sched_barrier(0);
                float mx = fmaxf(p0[0], p1[0]);
#pragma unroll
                for (int r = 1; r < 16; ++r) mx = fmaxf(mx, fmaxf(p0[r], p1[r]));
                mx = fmaxf(mx, __shfl_xor(mx, 32));
                const float m_new = fmaxf(m_run, mx), alpha = fast_exp2(m_run - m_new); m_run = m_new;
                float ps = 0.f;
#pragma unroll
                for (int r = 0; r < 16; ++r) { p0[r] = fast_exp2(p0[r] - m_new); p1[r] = fast_exp2(p1[r] - m_new); ps += p0[r] + p1[r]; }
                lsum = lsum * alpha + ps;
#pragma unroll
                for (int r = 0; r < 16; ++r) { o0[r] *= alpha; o1[r] *= alpha; }
                h16x8 pb[4];
#pragma unroll
                for (int e = 0; e < 8; ++e) { pb[0][e] = (h16)p0[e]; pb[1][e] = (h16)p0[8 + e]; pb[2][e] = (h16)p1[e]; pb[3][e] = (h16)p1[8 + e]; }
#pragma unroll
                for (int t = 0; t < 4; ++t) {
                    const h16x8 va = {vf[t][0][0], vf[t][0][1], vf[t][0][2], vf[t][0][3], vf[t][1][0], vf[t][1][1], vf[t][1][2], vf[t][1][3]};
                    const h16x8 vc2 = {vf[t][2][0], vf[t][2][1], vf[t][2][2], vf[t][2][3], vf[t][3][0], vf[t][3][1], vf[t][3][2], vf[t][3][3]};
                    o0 = __builtin_amdgcn_mfma_f32_32x32x16_f16(va, pb[t], o0, 0, 0, 0);
                    o1 = __builtin_amdgcn_mfma_f32_32x32x16_f16(vc2, pb[t], o1, 0, 0, 0);
                }
        };
        for (int J = 0; J < NT2; ++J) {
            const int buf = J & 1;
            if (J + 1 < NT2) LOADT(J + 1, rowbase, h);
            else if (has_next) LOADT(0, rowbase_n, h_n);
            if (2 * J <= my_last) compute(Kb + buf * 128 * KPITCH, Vb + buf * 64 * VPITCH);
            if (2 * J + 1 <= my_last) compute(Kb + buf * 128 * KPITCH + 64 * KPITCH, Vb + buf * 64 * VPITCH + 128);
            if (J + 1 == NT2 && has_next) LOADQ(qf, un);
            if (J + 1 < NT2 || has_next) STORET(buf ^ 1);
            LDS_BARRIER();
        }
        lsum += __shfl_xor(lsum, 32);
        const float inv = 1.f / lsum;
        LAS h16* sg = (LAS h16*)Sg;
#pragma unroll
        for (int r = 0; r < 16; ++r) { const int d = (r & 3) + 8 * (r >> 2) + 4 * hi; sg[r32 * 72 + d] = (h16)(o0[r] * inv); sg[r32 * 72 + 32 + d] = (h16)(o1[r] * inv); }
        asm volatile("s_waitcnt lgkmcnt(0)" ::: "memory");
#pragma unroll
        for (int i = 0; i < 4; ++i) { const int id = i * 64 + lane, row = id >> 3, c = id & 7;
            const u32x4 v = *(const LAS u32x4*)(Sg + row * 144 + c * 16);
            *(u32x4*)(YC + (rowbase + q0 + wid * 32 + row) * DM + h * 64 + c * 8) = v; }
        asm volatile("s_waitcnt lgkmcnt(0)" ::: "memory");
    }
#undef LOADT
#undef STORET
#undef LOADQ
}


#define XB_TMO      128
#define XB_XCNT(j)  (256  + 64 * (j))
#define XB_XSUB(j)  (1280 + 64 * (j))
#define XB_XGEN(j)  (2304 + 64 * (j))
#define XB_TOP      3328
#define XB_TOPGEN   3392
#define XCD_BAR_WORDS 3456
#define XB_SPIN_CAP (1u << 18)
__device__ __forceinline__ unsigned xb_ld(unsigned* p)              { return __hip_atomic_load(p, __ATOMIC_RELAXED, __HIP_MEMORY_SCOPE_AGENT); }
__device__ __forceinline__ unsigned xb_add(unsigned* p, unsigned v) { return __hip_atomic_fetch_add(p, v, __ATOMIC_RELAXED, __HIP_MEMORY_SCOPE_AGENT); }
__device__ __forceinline__ unsigned xb_xcc_id() { return (unsigned)__builtin_amdgcn_s_getreg((3 << 11) | 20) & 0xFu; }
#define XB_SPIN(cond, bar) do { unsigned _sp = 0; while (cond) { __builtin_amdgcn_s_sleep(1); \
    if ((++_sp & 255u) == 0u) { if (xb_ld(&(bar)[XB_TMO])) break; if (_sp > XB_SPIN_CAP) { atomicAdd(&(bar)[XB_TMO], 1u); break; } } } } while (0)
struct XcdBarrier { unsigned* bar; unsigned x; volatile LAS unsigned* st; };
__device__ __forceinline__ XcdBarrier xcd_barrier_post(unsigned* bar, volatile LAS unsigned* st) {
    XcdBarrier b; b.bar = bar; b.x = xb_xcc_id(); b.st = st;
    if (threadIdx.x == 0) (void)xb_add(&bar[XB_XCNT(b.x)], 1u);
    return b;
}
__device__ __forceinline__ void xcd_barrier_complete(unsigned* bar, unsigned x, unsigned& nloc, unsigned& nx) {
    const unsigned G = gridDim.x * gridDim.y * gridDim.z;
    unsigned sum, cnt, mine, sp = 0u;
    for (;;) {
        sum = 0u; cnt = 0u; mine = 0u;
#pragma unroll
        for (unsigned j = 0; j < 16; ++j) { const unsigned c = xb_ld(&bar[XB_XCNT(j)]); sum += c; cnt += (c > 0u) ? 1u : 0u; mine = (j == x) ? c : mine; }
        if (sum == G) break;
        __builtin_amdgcn_s_sleep(1);
        if ((++sp & 255u) == 0u) { if (xb_ld(&bar[XB_TMO])) break; if (sp > XB_SPIN_CAP) { atomicAdd(&bar[XB_TMO], 1u); break; } }
    }
    nloc = mine > 0u ? mine : 1u; nx = cnt > 0u ? cnt : 1u;
}
__device__ __forceinline__ void xcd_barrier(const XcdBarrier& b) {
    asm volatile("s_waitcnt vmcnt(0)" ::: "memory");
    __syncthreads();
    if (threadIdx.x == 0) {
        unsigned* bar = (unsigned*)(kparams()->ws + WS_BAR); asm volatile("" : "+v"(bar));
        __builtin_amdgcn_s_waitcnt(0);
        unsigned nloc = b.st[0], nx = b.st[1];
        if (nloc == 0u) { xcd_barrier_complete(bar, b.x, nloc, nx); b.st[0] = nloc; b.st[1] = nx; }
        const unsigned old = xb_add(&bar[XB_XSUB(b.x)], 1u);
        const unsigned gen = old / nloc;
        if (old + 1u == (gen + 1u) * nloc) {
            __builtin_amdgcn_fence(__ATOMIC_RELEASE, "agent");
            asm volatile("s_waitcnt vmcnt(0)" ::: "memory");
            const unsigned og = xb_add(&bar[XB_TOP], 1u);
            const unsigned tg = og / nx;
            if (og + 1u == (tg + 1u) * nx) xb_add(&bar[XB_TOPGEN], 1u);
            else XB_SPIN(xb_ld(&bar[XB_TOPGEN]) == tg, bar);
            __builtin_amdgcn_fence(__ATOMIC_ACQUIRE, "agent");
            xb_add(&bar[XB_XGEN(b.x)], 1u);
            asm volatile("s_waitcnt vmcnt(0)" ::: "memory");
        } else {
            XB_SPIN(xb_ld(&bar[XB_XGEN(b.x)]) == gen, bar);
            __builtin_amdgcn_fence(__ATOMIC_ACQUIRE, "agent");
            asm volatile("s_waitcnt vmcnt(0)" ::: "memory");
        }
    }
    __syncthreads();
}

struct GT { unsigned long long a, b, o; int lda, ldb, K, nM, nN, nZ1, nZ2, a_s1, a_s2, b_s1, b_s2, epi, ldc, rkind, bias, fold, st_in, st_out, cs, gidx, gl; float scale; int ph; };
__device__ const GT GTAB[] = {
    {WS_MEMH, WS_W + 0ull * 32 * MiB + WO_XWKV * 2, WS_XK, 1024, 1024, 1024, 32, 4, 1, 2, 0, 0, 0, 16777216, E_F16, 2048, 0, -1, 0, 0, 0, 0, 0, 0, 1.f, 1},
    {WS_W + 0ull * 32 * MiB + (WO_XWKV + 1024 * 1024) * 2, WS_MEMH, WS_XVT, 1024, 1024, 1024, 4, 32, 2, 1, 16777216, 0, 0, 0, E_F16, MEMT, 0, -1, 0, 0, 0, 0, 0, 0, 1.f, 1},
    {WS_XH, WS_W + 0ull * 32 * MiB + WO_WIN * 2, WS_PROJ, 1024, 1024, 1024, 256, 7, 1, 1, 0, 0, 0, 0, E_INPROJ, 0, 0, (int)WS_BIAS, 0, 0, 0, 0, 0, 0, 1.f, 1},
    {WS_PROJ, WS_W + 0ull * 32 * MiB + WO_WUQ * 2, WS_Q, PROJW, 256, 256, 256, 3, 1, 1, 0, 0, 0, 0, E_QUP, 0, 0, -1, 0, 0, 0, 0, 0, 0, 1.f, 3},
    {WS_PROJ + 512, WS_W + 0ull * 32 * MiB + WO_WUK * 2, WS_KN, PROJW, 256, 256, 256, 2, 1, 1, 0, 0, 0, 0, E_KUP, 0, 0, -1, 0, 0, 0, 0, 0, 0, 1.f, 3},
    {WS_W + 0ull * 32 * MiB + WO_WUV * 2, WS_PROJ + 512, WS_VT, 256, PROJW, 256, 2, 256, 1, 1, 0, 0, 0, 0, E_VTUP, 0, 0, -1, 0, 0, 0, 0, 0, 0, 1.f, 3},
    {WS_YCAT, WS_W + 0ull * 32 * MiB + WO_WO * 2, 0, 1024, 1024, 1024, 256, 4, 1, 1, 0, 0, 0, 0, E_RESID0, 0, 1, -1, 0, 0, 0, 0, 0, 0, 1.f, 5},
    {WS_XH, WS_W + 0ull * 32 * MiB + WO_XWQ * 2, WS_XQ, 1024, 1024, 1024, 256, 4, 1, 1, 0, 0, 0, 0, E_F16, 1024, 0, -1, 1, 0, 0, 0 * NCS + 1792, 0, 0, XQSCALE, 7},
    {WS_XQ, WS_XK + 0 * 2048, WS_P, 1024, 2048, 256, 8, 1, 32, 4, SEQ * 1024, 256, 256 * 2048, 256, E_SOFTMAX, 0, 0, -1, 0, 0, 0, 0, 0, 0, 1.f, 8},
    {WS_P, WS_XVT + 0ull * 16 * MiB, WS_XO, 1024, MEMT, 256, 8, 1, 32, 4, SEQ * 1024, 256, 256, 256 * MEMT, E_F16, 1024, 0, -1, 0, 0, 0, 0, 0, 0, 1.f, 9},
    {WS_XO, WS_W + 0ull * 32 * MiB + WO_XWO * 2, 0, 1024, 1024, 1024, 256, 4, 1, 1, 0, 0, 0, 0, E_RESID, 0, 2, -1, 1, 0, 1, 0, 14, 0, 1.f, 10},
    {WS_XH, WS_W + 0ull * 32 * MiB + WO_FWIN * 2, WS_H, 1024, 1024, 1024, 256, 22, 1, 1, 0, 0, 0, 0, E_SWIGLU, 0, 0, -1, 1, 1, 0, 0 * NCS + 2816, 0, 0, 1.f, 12},
    {WS_H, WS_W + 0ull * 32 * MiB + WO_FWD * 2, 0, FFH, FFH, FFH, 256, 4, 1, 1, 0, 0, 0, 0, E_RESID, 0, 2, -1, 1, 1, 0, 0, 19, 0, 1.f, 13},
    {WS_XH, WS_W + 1ull * 32 * MiB + WO_WIN * 2, WS_PROJ, 1024, 1024, 1024, 256, 7, 1, 1, 0, 0, 0, 0, E_INPROJ, 0, 0, (int)WS_BIAS + 1 * 1792 * 4, 1, 0, 0, 1 * NCS, 0, 0, 1.f, 15},
    {WS_PROJ, WS_W + 1ull * 32 * MiB + WO_WUQ * 2, WS_Q, PROJW, 256, 256, 256, 3, 1, 1, 0, 0, 0, 0, E_QUP, 0, 0, -1, 0, 0, 0, 0, 0, 0, 1.f, 16},
    {WS_PROJ + 512, WS_W + 1ull * 32 * MiB + WO_WUK * 2, WS_KN, PROJW, 256, 256, 256, 2, 1, 1, 0, 0, 0, 0, E_KUP, 0, 0, -1, 0, 0, 0, 0, 0, 0, 1.f, 16},
    {WS_W + 1ull * 32 * MiB + WO_WUV * 2, WS_PROJ + 512, WS_VT, 256, PROJW, 256, 2, 256, 1, 1, 0, 0, 0, 0, E_VTUP, 0, 0, -1, 0, 0, 0, 0, 0, 0, 1.f, 16},
    {WS_YCAT, WS_W + 1ull * 32 * MiB + WO_WO * 2, 0, 1024, 1024, 1024, 256, 4, 1, 1, 0, 0, 0, 0, E_RESID, 0, 2, -1, 1, 0, 1, 0, 23, 0, 1.f, 18},
    {WS_XH, WS_W + 1ull * 32 * MiB + WO_XWQ * 2, WS_XQ, 1024, 1024, 1024, 256, 4, 1, 1, 0, 0, 0, 0, E_F16, 1024, 0, -1, 1, 1, 0, 1 * NCS + 1792, 0, 0, XQSCALE, 20},
    {WS_XQ, WS_XK + 1 * 2048, WS_P, 1024, 2048, 256, 8, 1, 32, 4, SEQ * 1024, 256, 256 * 2048, 256, E_SOFTMAX, 0, 0, -1, 0, 0, 0, 0, 0, 0, 1.f, 21},
    {WS_P, WS_XVT + 1ull * 16 * MiB, WS_XO, 1024, MEMT, 256, 8, 1, 32, 4, SEQ * 1024, 256, 256, 256 * MEMT, E_F16, 1024, 0, -1, 0, 0, 0, 0, 0, 0, 1.f, 22},
    {WS_XO, WS_W + 1ull * 32 * MiB + WO_XWO * 2, 0, 1024, 1024, 1024, 256, 4, 1, 1, 0, 0, 0, 0, E_RESID, 0, 2, -1, 1, 1, 0, 0, 14, 1, 1.f, 23},
    {WS_XH, WS_W + 1ull * 32 * MiB + WO_FWIN * 2, WS_H, 1024, 1024, 1024, 256, 22, 1, 1, 0, 0, 0, 0, E_SWIGLU, 0, 0, -1, 1, 0, 0, 1 * NCS + 2816, 0, 0, 1.f, 25},
    {WS_H, WS_W + 1ull * 32 * MiB + WO_FWD * 2, 0, FFH, FFH, FFH, 256, 4, 1, 1, 0, 0, 0, 0, E_RESID, 0, 2, -1, 1, 0, 1, 0, 19, 1, 1.f, 26},
    {0, 0, 0, 0, 0, 0, 0, 0, 0, 0, 0, 0, 0, 0, 0, 0, 0, 0, 0, 0, 0, 0, 0, 0, 0.f, 99},
};
__device__ __forceinline__ void load_gemm(GemmDesc& g, int ti, KP P) {
    const GT& t = GTAB[ti]; unsigned char* ws = P->ws;
    g.A = (const h16*)(ws + t.a); g.B = (const h16*)(ws + t.b); g.lda = t.lda; g.ldb = t.ldb; g.K = t.K; g.nM = t.nM; g.nN = t.nN; g.nZ1 = t.nZ1; g.nZ2 = t.nZ2;
    g.a_s1 = t.a_s1; g.a_s2 = t.a_s2; g.b_s1 = t.b_s1; g.b_s2 = t.b_s2; g.epi = t.epi; g.ldc = t.ldc; g.scale = t.scale; g.fold = t.fold;
    g.out = (void*)(ws + ((t.epi == E_RESID || t.epi == E_RESID0) ? WS_XH : t.o));
    g.st_in = (const float*)(ws + WS_ST) + (size_t)t.st_in * TT * 8; g.st_out = (float*)(ws + WS_ST) + (size_t)t.st_out * TT * 8;
    g.cs = (const float*)(ws + WS_CSBW) + t.cs;
    if (t.rkind == 1) { g.res = P->in[0]; g.bias = nullptr; }
    else if (t.rkind == 2) { g.res = P->in[t.gidx] + t.gl * DM; g.bias = P->in[t.gidx + 1] + t.gl * DM; }
    else { g.res = nullptr; g.bias = (const float*)(ws + (t.bias < 0 ? 0 : t.bias)); }
}

__global__ void __launch_bounds__(512, 2) fwd_megakernel(Params Pval) {
    extern __shared__ __attribute__((aligned(16))) unsigned char lds_raw[];
    LAS unsigned char* lds = (LAS unsigned char*)lds_raw;
    cg::grid_group grid = cg::this_grid();
    volatile LAS unsigned* bst = (volatile LAS unsigned*)(lds + 131072 + 8192 + 1024);
    if (threadIdx.x < 2) bst[threadIdx.x] = 0u;
    XcdBarrier xbar; xbar.bar = nullptr; xbar.x = 0; xbar.st = bst;
    int ti = 0;
    {
        KP P = kparams();
        if (bid_here() == 0) { unsigned* bw = (unsigned*)(P->ws + WS_BAR); for (int i = tid_here(); i < XCD_BAR_WORDS; i += 512) bw[i] = 0u; }
        prologue(lds, P);
        grid.sync();
        xbar = xcd_barrier_post((unsigned*)(P->ws + WS_BAR), bst);
    }
    for (int ph = 1; ph < 28; ++ph) {
        { const int sq = ph < 2 ? -1 : (ph - 2) % 13; if (ph == 2 || sq == 4 || sq == 9 || (sq == 12 && ph != 27)) continue; }
        KP P = kparams();
        {
            const int l = ph < 2 ? 0 : (ph - 2) / 13, s = ph < 2 ? -1 : (ph - 2) % 13;
            if (s == 1) conv_phase(lds, P, l);
            if (s == 2) attn_phase(lds, P);
            if (ph == 1) csbw_finalize(P);
            if (s == 12 && l == 1) ln_final(P, P->in[23] + DM, P->in[24] + DM);
            for (; GTAB[ti].ph == ph; ++ti) {
              {
                GemmDesc g; load_gemm(g, ti, P);
                unsigned char* ws = P->ws;
                __syncthreads();
                switch (g.epi) {
                case E_INPROJ: gemm_run<E_INPROJ>(lds, g, ws); break;
                case E_QUP: gemm_run<E_QUP>(lds, g, ws); break;
                case E_KUP: gemm_run<E_KUP>(lds, g, ws); break;
                case E_VTUP: gemm_run<E_VTUP>(lds, g, ws); break;
                case E_F16: gemm_run<E_F16>(lds, g, ws); break;
                case E_RESID: gemm_run<E_RESID>(lds, g, ws); break;
                case E_RESID0: gemm_run<E_RESID0>(lds, g, ws); break;
                case E_SOFTMAX: gemm_run<E_SOFTMAX>(lds, g, ws); break;
                default: gemm_run<E_SWIGLU>(lds, g, ws); break;
                }
                __syncthreads();
              }
            }
        }
        if (ph != 27) xcd_barrier(xbar);
    }
}

extern "C" void kernel_launch(void* const* d_in, const int* in_sizes, int n_in, void* d_out, int out_size, void* d_ws, size_t ws_size, hipStream_t stream) {
    static int grid_blocks = 0;
    if (!grid_blocks) {
        if (n_in != 25 || ws_size < WS_END) { fprintf(stderr, "kernel_launch: unexpected n_in %d / ws_size %zu\n", n_in, ws_size); grid_blocks = -1; return; }
        int dev = 0, cus = 0, per_cu = 0;
        hipGetDevice(&dev);
        hipDeviceGetAttribute(&cus, hipDeviceAttributeMultiprocessorCount, dev);
        if (hipFuncSetAttribute((const void*)fwd_megakernel, hipFuncAttributeMaxDynamicSharedMemorySize, LDS_BYTES) != hipSuccess) fprintf(stderr, "kernel_launch: hipFuncSetAttribute failed\n");
        hipOccupancyMaxActiveBlocksPerMultiprocessor(&per_cu, (const void*)fwd_megakernel, 512, LDS_BYTES);
        if (per_cu < 1) { fprintf(stderr, "kernel_launch: occupancy query gave %d\n", per_cu); per_cu = 1; }
        grid_blocks = cus * 1;
        (void)hipGetLastError();
    }
    if (grid_blocks < 0) return;
    Params p{};
    for (int i = 0; i < 25; ++i) p.in[i] = (const float*)d_in[i];
    p.pos = (const int*)d_in[2];
    p.out = (float*)d_out; p.ws = (unsigned char*)d_ws;
    void* args[] = {&p};
    hipError_t e = hipLaunchCooperativeKernel((const void*)fwd_megakernel, dim3(grid_blocks), dim3(512), args, LDS_BYTES, stream);
    if (e != hipSuccess) fprintf(stderr, "cooperative launch failed: %s (grid %d)\n", hipGetErrorString(e), grid_blocks);
}
```

```cpp
#include <hip/hip_runtime.h>
#include <hip/hip_cooperative_groups.h>
#include <cstdio>
#include <cstdint>
namespace cg = cooperative_groups;

#define LAS __attribute__((address_space(3)))
typedef _Float16 h16;
typedef _Float16 h16x8 __attribute__((ext_vector_type(8)));
typedef _Float16 h16x4 __attribute__((ext_vector_type(4)));
typedef _Float16 h16x2 __attribute__((ext_vector_type(2)));
typedef float f32x4 __attribute__((ext_vector_type(4)));
typedef float f32x2 __attribute__((ext_vector_type(2)));
typedef float f32x16 __attribute__((ext_vector_type(16)));
typedef unsigned u32x4 __attribute__((ext_vector_type(4)));

constexpr int TT = 65536, DM = 1024, SEQ = 2048, NB = 32, MEMT = 8192, FFH = 2816;
constexpr int PROJW = 1536;
constexpr float ALPHA = 1.4142135623730951f;
constexpr float QSCALE = 0.14724444602590306f;
constexpr float XQSCALE = 0.09016844005556021f;
constexpr size_t MiB = 1u << 20;
constexpr size_t WS_BIAS = 0;
constexpr size_t WS_W = 1 * MiB;
constexpr size_t WS_COS = 65 * MiB, WS_SIN = 69 * MiB, WS_SSQ = 73 * MiB;
constexpr size_t WS_MEMH = 76 * MiB, WS_XK = 92 * MiB, WS_XVT = 124 * MiB;
constexpr size_t WS_XH = 156 * MiB, WS_YCAT = 284 * MiB, WS_VT = 412 * MiB, WS_KR = 476 * MiB, WS_BIG = 480 * MiB;
constexpr size_t WS_PROJ = WS_BIG, WS_Q = WS_BIG + 224 * MiB, WS_KN = WS_BIG + 320 * MiB;
constexpr size_t WS_XQ = WS_BIG, WS_P = WS_BIG + 128 * MiB, WS_XO = WS_BIG + 256 * MiB, WS_H = WS_BIG;
constexpr size_t WS_PART = 864 * MiB;
constexpr size_t WS_CSBW = 867 * MiB;
constexpr size_t WS_ST = 868 * MiB;
constexpr size_t WS_END = 872 * MiB;
constexpr int NCS = 1792 + 1024 + 5632;
constexpr size_t WO_WIN = 0, WO_WUQ = WO_WIN + 1792 * 1024, WO_WUK = WO_WUQ + 768 * 256, WO_WUV = WO_WUK + 512 * 256,
                 WO_WO = WO_WUV + 512 * 256, WO_XWQ = WO_WO + 1024 * 1024, WO_XWKV = WO_XWQ + 1024 * 1024,
                 WO_XWO = WO_XWKV + 2048 * 1024, WO_FWIN = WO_XWO + 1024 * 1024, WO_FWD = WO_FWIN + 5632 * 1024,
                 WO_END = WO_FWD + 1024 * 2816;
static_assert(WO_END * 2 <= 32 * MiB, "weights per layer");
constexpr int LDS_STATS = 131072 + 8192 + 1024 + 64;
constexpr int LDS_COLS = LDS_STATS + 2 * 8192;
constexpr int LDS_BYTES = LDS_COLS + 2 * 2048;
constexpr size_t WS_BAR = 256 * 1024;

struct Params {
    const float* in[25];
    const int* pos;
    float* out;
    unsigned char* ws;
};

typedef const __attribute__((address_space(4))) Params* KP;
__device__ __forceinline__ KP kparams() { KP p = (KP)__builtin_amdgcn_kernarg_segment_ptr(); asm volatile("" : "+s"(p)); return p; }

__device__ __forceinline__ int tid_here() { int t = threadIdx.x; asm volatile("" : "+v"(t)); return t; }
__device__ __forceinline__ int bid_here() { int b = blockIdx.x; asm volatile("" : "+s"(b)); return b; }

__device__ __forceinline__ float wave_sum(float v) {
#pragma unroll
    for (int o = 1; o < 64; o <<= 1) v += __shfl_xor(v, o);
    return v;
}
__device__ __forceinline__ h16x4 cvt4(f32x4 v) { h16x4 r; r[0] = (h16)v[0]; r[1] = (h16)v[1]; r[2] = (h16)v[2]; r[3] = (h16)v[3]; return r; }
__device__ __forceinline__ float fast_exp2(float x) { return __builtin_amdgcn_exp2f(x); }

constexpr int BM = 256, BK = 64, HALF = 128, HTB = HALF * BK * 2, NXCD = 8, WGM = 8;
__device__ __forceinline__ int lds_byte(int r, int c) { const int st = (r >> 4) * 2 + (c >> 5), rr = r & 15, cc = c & 31, ob = rr * 64 + cc * 2; return st * 1024 + (ob ^ (((ob >> 9) & 1) << 5)); }
__device__ __forceinline__ void stage_rc(int b, int& R, int& C) { const int st = b / 1024, sb = b % 1024, swz = sb ^ (((sb >> 9) & 1) << 5); R = (st >> 1) * 16 + swz / 64; C = (st & 1) * 32 + (swz % 64) / 2; }

__device__ __forceinline__ int perm32(int rho) { const int n = rho >> 4, i = rho & 15; return 8 * (i >> 2) + 4 * n + (i & 3); }
enum { E_INPROJ = 0, E_QUP, E_KUP, E_VTUP, E_F16, E_RESID, E_SOFTMAX, E_SWIGLU, E_RESID0 };
struct GemmDesc {
    const h16* A; const h16* B; int lda, ldb, K;
    int nM, nN, nZ1, nZ2;
    int a_s1, a_s2, b_s1, b_s2;
    int epi;
    void* out; int ldc; float scale; const float* res; const float* bias;
    const float* st_in; float* st_out; const float* cs; int fold;
};
struct Unit { int row0, col0, pn; unsigned a, b; };

__device__ __forceinline__ bool unit_next(const GemmDesc& g, int i, int G, int c, Unit& u) {
    const int nwg = g.nZ1 * g.nZ2 * g.nM * g.nN;
    const long L = (long)i * G + c; if (L >= nwg) return false;
    int zb = 0, zh = 0, pm, pn;
    if (g.nZ1 * g.nZ2 == 1) {
        const int nM = g.nM, nN = g.nN;
        int wgid = (int)L; { const int q = nwg / NXCD, r = nwg % NXCD, xcd = wgid % NXCD, off = wgid / NXCD; wgid = (xcd < r ? xcd * (q + 1) : r * (q + 1) + (xcd - r) * q) + off; }
        const int nig = WGM * nN, gid = wgid / nig, fm = gid * WGM, gsz = (nM - fm) < WGM ? (nM - fm) : WGM;
        pm = fm + ((wgid % nig) % gsz); pn = (wgid % nig) / gsz;
    } else {
        int r = (int)L; pn = r % g.nN; r /= g.nN; pm = r % g.nM; r /= g.nM; zh = r % g.nZ2; zb = r / g.nZ2;
    }
    u.row0 = (zb * g.nM + pm) * BM; u.col0 = (zh * g.nN + pn) * BM; u.pn = pn;
    u.a = (unsigned)(zb * g.a_s1 + zh * g.a_s2 + pm * BM * g.lda) * 2u;
    u.b = (unsigned)(zb * g.b_s1 + zh * g.b_s2 + pn * BM * g.ldb) * 2u;
    return true;
}

__device__ __forceinline__ void row_stats(const LAS float* st, int row, float& mu, float& rstd) {
    const f32x4 a = *(const LAS f32x4*)(st + row * 8), b = *(const LAS f32x4*)(st + row * 8 + 4);
    mu = ((a[0] + a[2]) + (b[0] + b[2])) * (1.f / DM);
    const float var = ((a[1] + a[3]) + (b[1] + b[3])) * (1.f / DM) - mu * mu;
    rstd = __builtin_amdgcn_rsqf(var + 1e-5f);
}
template <int CN> __device__ __forceinline__ void fold_acc(f32x4 (&acc)[2][2][4][2], const LAS float* stl, const LAS float* ctl, int rloc, int cloc) {
    f32x4 cs[2][2], bw[2][2];
#pragma unroll
    for (int bj = 0; bj < 2; ++bj)
#pragma unroll
        for (int n = 0; n < 2; ++n) { cs[bj][n] = *(const LAS f32x4*)(ctl + cloc + bj * HALF + n * CN); bw[bj][n] = *(const LAS f32x4*)(ctl + 256 + cloc + bj * HALF + n * CN); }
#pragma unroll
    for (int ai = 0; ai < 2; ++ai)
#pragma unroll
        for (int m = 0; m < 4; ++m) { float mu, rstd; row_stats(stl, rloc + ai * HALF + m * 16, mu, rstd);
#pragma unroll
            for (int bj = 0; bj < 2; ++bj)
#pragma unroll
                for (int n = 0; n < 2; ++n) acc[ai][bj][m][n] = (acc[ai][bj][m][n] - cs[bj][n] * mu) * rstd + bw[bj][n]; }
}

#define LDS_BARRIER() asm volatile("s_waitcnt lgkmcnt(0)\n\ts_barrier" ::: "memory")
template <int EPI> __device__ __forceinline__ void epilogue(const GemmDesc& g, const Unit& u, f32x4 (&acc)[2][2][4][2], int wr, int wc, int fr, int fq,
                                         LAS unsigned char* lds, unsigned char* ws, const LAS float* stl, const LAS float* ctl) {
    const float* COS = (const float*)(ws + WS_COS); const float* SIN = (const float*)(ws + WS_SIN); float* SSQ = (float*)(ws + WS_SSQ);
    const int rbase = u.row0 + wr * 64 + fr;
    constexpr int CN = 4;
    const int cbase = u.col0 + wc * 32 + 8 * fq;
    if (EPI == E_INPROJ || EPI == E_F16 || EPI == E_SWIGLU) { if (g.fold) fold_acc<CN>(acc, stl, ctl, wr * 64 + fr, cbase - u.col0); }
    switch (EPI) {
    case E_INPROJ: {
        if (u.pn < 6) {
            h16* O = (h16*)g.out;
            f32x4 bv[2][2];
#pragma unroll
            for (int bj = 0; bj < 2; ++bj)
#pragma unroll
                for (int n = 0; n < 2; ++n) bv[bj][n] = *(const f32x4*)(g.bias + cbase + bj * HALF + n * CN);
#pragma unroll
            for (int ai = 0; ai < 2; ++ai)
#pragma unroll
                for (int m = 0; m < 4; ++m) {
                    const int row = rbase + ai * HALF + m * 16; float ss = 0.f;
#pragma unroll
                    for (int bj = 0; bj < 2; ++bj)
#pragma unroll
                        for (int n = 0; n < 2; ++n) { const f32x4 v = acc[ai][bj][m][n] + bv[bj][n]; ss += (v[0] * v[0] + v[1] * v[1]) + (v[2] * v[2] + v[3] * v[3]);
                            *(h16x4*)(O + (size_t)row * PROJW + cbase + bj * HALF + n * CN) = cvt4(v); }
                    if (u.pn < 2) { ss += __shfl_xor(ss, 16); ss += __shfl_xor(ss, 32); if (fq == 0) SSQ[(size_t)row * 8 + u.pn * 4 + wc] = ss; }
                }
        } else if (wc == 0) {
            h16* KR = (h16*)(ws + WS_KR);
            const f32x4 b0 = *(const f32x4*)(g.bias + 1536 + 4 * fq), b1 = *(const f32x4*)(g.bias + 1536 + 16 + 4 * fq);
#pragma unroll
            for (int ai = 0; ai < 2; ++ai)
#pragma unroll
                for (int m = 0; m < 4; ++m) {
                    const int row = rbase + ai * HALF + m * 16;
                    const f32x4 c = *(const f32x4*)(COS + (size_t)row * 16 + 4 * fq), s = *(const f32x4*)(SIN + (size_t)row * 16 + 4 * fq);
                    const f32x4 v0 = acc[ai][0][m][0] + b0, v1 = acc[ai][0][m][1] + b1;
                    *(h16x4*)(KR + (size_t)row * 32 + 4 * fq) = cvt4(v0 * c - v1 * s);
                    *(h16x4*)(KR + (size_t)row * 32 + 16 + 4 * fq) = cvt4(v0 * s + v1 * c);
                }
        }
    } break;
    case E_QUP: {
        h16* O = (h16*)g.out;
#pragma unroll
        for (int ai = 0; ai < 2; ++ai) {
            float scr_[4]; f32x4 cr[4], sr[4];
#pragma unroll
            for (int m = 0; m < 4; ++m) { const int row = rbase + ai * HALF + m * 16;
                const f32x4 q4 = *(const LAS f32x4*)(stl + (row - u.row0) * 8);
                scr_[m] = QSCALE * __builtin_amdgcn_rsqf(((q4[0] + q4[1]) + (q4[2] + q4[3])) * (1.f / 256.f) + 1e-6f);
                cr[m] = *(const f32x4*)(COS + (size_t)row * 16 + 4 * fq); sr[m] = *(const f32x4*)(SIN + (size_t)row * 16 + 4 * fq); }
#pragma unroll
            for (int m = 0; m < 4; ++m) {
                const int row = rbase + ai * HALF + m * 16;
                const float sc = scr_[m]; const f32x4 c = cr[m], s = sr[m];
#pragma unroll
                for (int bj = 0; bj < 2; ++bj) {
                    const int gcol = u.col0 + bj * HALF + wc * 32;
                    const f32x4 v0 = acc[ai][bj][m][0] * sc, v1 = acc[ai][bj][m][1] * sc;
                    if ((gcol >> 5) % 3 == 2) {
                        *(h16x4*)(O + (size_t)row * 768 + gcol + 4 * fq) = cvt4(v0 * c - v1 * s);
                        *(h16x4*)(O + (size_t)row * 768 + gcol + 16 + 4 * fq) = cvt4(v0 * s + v1 * c);
                    } else {
                        *(h16x4*)(O + (size_t)row * 768 + gcol + 8 * fq) = cvt4(v0);
                        *(h16x4*)(O + (size_t)row * 768 + gcol + 8 * fq + 4) = cvt4(v1);
                    }
                }
            }
        }
    } break;
    case E_KUP: {
        h16* O = (h16*)g.out;
        float scr_[2][4];
#pragma unroll
        for (int ai = 0; ai < 2; ++ai)
#pragma unroll
            for (int m = 0; m < 4; ++m) { const f32x4 q4 = *(const LAS f32x4*)(stl + (rbase - u.row0 + ai * HALF + m * 16) * 8 + 4);
                scr_[ai][m] = __builtin_amdgcn_rsqf(((q4[0] + q4[1]) + (q4[2] + q4[3])) * (1.f / 256.f) + 1e-6f); }
#pragma unroll
        for (int ai = 0; ai < 2; ++ai)
#pragma unroll
            for (int m = 0; m < 4; ++m) {
                const int row = rbase + ai * HALF + m * 16; const float sc = scr_[ai][m];
#pragma unroll
                for (int bj = 0; bj < 2; ++bj)
#pragma unroll
                    for (int n = 0; n < 2; ++n) *(h16x4*)(O + (size_t)row * 512 + cbase + bj * HALF + n * CN) = cvt4(acc[ai][bj][m][n] * sc);
            }
    } break;
    case E_VTUP: {
        h16* O = (h16*)g.out;
        f32x4 sc[2][2];
#pragma unroll
        for (int bj = 0; bj < 2; ++bj)
#pragma unroll
            for (int n = 0; n < 2; ++n)
#pragma unroll
                for (int j = 0; j < 4; ++j) { const f32x4 q4 = *(const LAS f32x4*)(stl + (cbase - u.col0 + bj * HALF + n * CN + j) * 8 + 4);
                    sc[bj][n][j] = __builtin_amdgcn_rsqf(((q4[0] + q4[1]) + (q4[2] + q4[3])) * (1.f / 256.f) + 1e-6f); }
#pragma unroll
        for (int ai = 0; ai < 2; ++ai)
#pragma unroll
            for (int m = 0; m < 4; ++m) {
                const int row = rbase + ai * HALF + m * 16;
#pragma unroll
                for (int bj = 0; bj < 2; ++bj)
#pragma unroll
                    for (int n = 0; n < 2; ++n) *(h16x4*)(O + (size_t)row * TT + cbase + bj * HALF + n * CN) = cvt4(acc[ai][bj][m][n] * sc[bj][n]);
            }
    } break;
    case E_F16: {
        h16* O = (h16*)g.out; const float sc = g.scale; const int ldc = g.ldc;
#pragma unroll
        for (int ai = 0; ai < 2; ++ai)
#pragma unroll
            for (int m = 0; m < 4; ++m) {
                const int row = rbase + ai * HALF + m * 16;
#pragma unroll
                for (int bj = 0; bj < 2; ++bj)
#pragma unroll
                    for (int n = 0; n < 2; ++n) *(h16x4*)(O + (size_t)row * ldc + cbase + bj * HALF + n * CN) = cvt4(acc[ai][bj][m][n] * sc);
            }
    } break;
    case E_RESID0:
    case E_RESID: {
        constexpr bool FOLD = (EPI == E_RESID);
        const h16* ZH = (const h16*)(ws + WS_XH); h16* ZO = (h16*)g.out;
        LAS f32x2* PP = (LAS f32x2*)(lds + 131072);
#define RS_LOAD(ZB, XB, ai_, m0_) do { _Pragma("unroll") for (int mm = 0; mm < 2; ++mm) { const size_t off_ = (size_t)(rbase + (ai_) * HALF + ((m0_) + mm) * 16) * DM + cbase; \
            _Pragma("unroll") for (int bj = 0; bj < 2; ++bj) { if (FOLD) ZB[mm][bj] = *(const h16x8*)(ZH + off_ + bj * HALF); \
                else { XB[mm][bj][0] = *(const f32x4*)(g.res + off_ + bj * HALF); XB[mm][bj][1] = *(const f32x4*)(g.res + off_ + bj * HALF + 4); } } } } while (0)
#define RS_PROC(ZB, XB, ai_, m0_) do { _Pragma("unroll") for (int mm = 0; mm < 2; ++mm) { const int m = (m0_) + mm; \
            const int row = rbase + (ai_) * HALF + m * 16; const size_t off = (size_t)row * DM + cbase; \
            float mu_ = 0.f, rstd_ = 1.f; if (FOLD) row_stats(stl, row - u.row0, mu_, rstd_); const float nmr_ = -mu_ * rstd_; \
            const LAS float* ctr = ctl + (cbase - u.col0); asm volatile("" : "+v"(ctr)); \
            float ps = 0.f, pss = 0.f; \
            _Pragma("unroll") for (int bj = 0; bj < 2; ++bj) { h16x8 zo; \
                _Pragma("unroll") for (int n = 0; n < 2; ++n) { f32x4 x; \
                    if (FOLD) { const f32x4 gvv = *(const LAS f32x4*)(ctr + bj * HALF + n * CN), bvv = *(const LAS f32x4*)(ctr + 256 + bj * HALF + n * CN); \
                        _Pragma("unroll") for (int j = 0; j < 4; ++j) x[j] = __builtin_fmaf(__builtin_fmaf((float)ZB[mm][bj][4 * n + j], rstd_, nmr_), gvv[j], bvv[j]); } \
                    else x = XB[mm][bj][n]; \
                    const f32x4 z = x * ALPHA + acc[ai_][bj][m][n]; \
                    ps += (z[0] + z[1]) + (z[2] + z[3]); pss += (z[0] * z[0] + z[1] * z[1]) + (z[2] * z[2] + z[3] * z[3]); \
                    _Pragma("unroll") for (int j = 0; j < 4; ++j) zo[4 * n + j] = (h16)z[j]; } \
                *(h16x8*)(ZO + off + bj * HALF) = zo; } \
            ps += __shfl_xor(ps, 16); ps += __shfl_xor(ps, 32); pss += __shfl_xor(pss, 16); pss += __shfl_xor(pss, 32); \
            if (fq == 0) PP[((ai_) * HALF + wr * 64 + m * 16 + fr) * 4 + wc] = (f32x2){ps, pss}; } } while (0)
        if (FOLD) {
            h16x8 zA[2][2], zB[2][2]; f32x4 xd[2][2][2];
            RS_LOAD(zA, xd, 0, 0); RS_LOAD(zB, xd, 0, 2);
            RS_PROC(zA, xd, 0, 0); RS_LOAD(zA, xd, 1, 0);
            RS_PROC(zB, xd, 0, 2); RS_LOAD(zB, xd, 1, 2);
            RS_PROC(zA, xd, 1, 0);
            RS_PROC(zB, xd, 1, 2);
        } else {
            h16x8 zd[2][2]; f32x4 xA[2][2][2];
#pragma unroll
            for (int ai = 0; ai < 2; ++ai)
#pragma unroll
                for (int m0 = 0; m0 < 4; m0 += 2) { RS_LOAD(zd, xA, ai, m0); RS_PROC(zd, xA, ai, m0); }
        }
#undef RS_LOAD
#undef RS_PROC
        LDS_BARRIER();
        { const int t = wr * 256 + wc * 64 + fq * 16 + fr;
          if (t < 256) { const f32x2 a = PP[t * 4 + 0], b = PP[t * 4 + 1], c = PP[t * 4 + 2], d = PP[t * 4 + 3];
              *(f32x2*)(g.st_out + (size_t)(u.row0 + t) * 8 + u.pn * 2) = (f32x2){(a[0] + b[0]) + (c[0] + d[0]), (a[1] + b[1]) + (c[1] + d[1])}; } }
    } break;
    case E_SOFTMAX: {
        h16* O = (h16*)g.out;
        LAS float* PM = (LAS float*)(lds + 131072);
        LAS float* PS = (LAS float*)(lds + 131072 + 4096);
        float mx[2][4];
#pragma unroll
        for (int ai = 0; ai < 2; ++ai)
#pragma unroll
            for (int m = 0; m < 4; ++m) {
                float v = -INFINITY;
#pragma unroll
                for (int bj = 0; bj < 2; ++bj)
#pragma unroll
                    for (int n = 0; n < 2; ++n) { const f32x4 x = acc[ai][bj][m][n]; v = fmaxf(v, fmaxf(fmaxf(x[0], x[1]), fmaxf(x[2], x[3]))); }
                v = fmaxf(v, __shfl_xor(v, 16)); v = fmaxf(v, __shfl_xor(v, 32));
                if (fq == 0) PM[(ai * HALF + wr * 64 + m * 16 + fr) * 4 + wc] = v;
            }
        LDS_BARRIER();
#pragma unroll
        for (int ai = 0; ai < 2; ++ai)
#pragma unroll
            for (int m = 0; m < 4; ++m) {
                const f32x4 p = *(const LAS f32x4*)(PM + (ai * HALF + wr * 64 + m * 16 + fr) * 4);
                const float mm = fmaxf(fmaxf(p[0], p[1]), fmaxf(p[2], p[3])); mx[ai][m] = mm; float s = 0.f;
#pragma unroll
                for (int bj = 0; bj < 2; ++bj)
#pragma unroll
                    for (int n = 0; n < 2; ++n) { f32x4 x = acc[ai][bj][m][n];
#pragma unroll
                        for (int j = 0; j < 4; ++j) { x[j] = fast_exp2(x[j] - mm); s += x[j]; }
                        acc[ai][bj][m][n] = x; }
                s += __shfl_xor(s, 16); s += __shfl_xor(s, 32);
                if (fq == 0) PS[(ai * HALF + wr * 64 + m * 16 + fr) * 4 + wc] = s;
            }
        LDS_BARRIER();
#pragma unroll
        for (int ai = 0; ai < 2; ++ai)
#pragma unroll
            for (int m = 0; m < 4; ++m) {
                const f32x4 p = *(const LAS f32x4*)(PS + (ai * HALF + wr * 64 + m * 16 + fr) * 4);
                const float inv = 1.f / ((p[0] + p[1]) + (p[2] + p[3]));
                const int row = rbase + ai * HALF + m * 16;
#pragma unroll
                for (int bj = 0; bj < 2; ++bj)
#pragma unroll
                    for (int n = 0; n < 2; ++n) *(h16x4*)(O + (size_t)row * DM + cbase + bj * HALF + n * CN) = cvt4(acc[ai][bj][m][n] * inv);
            }
        (void)mx;
    } break;
    case E_SWIGLU: {
        h16* O = (h16*)g.out;
#pragma unroll
        for (int ai = 0; ai < 2; ++ai)
#pragma unroll
            for (int m = 0; m < 4; ++m) {
                const int row = rbase + ai * HALF + m * 16;
#pragma unroll
                for (int n = 0; n < 2; ++n) { const f32x4 gt = acc[ai][0][m][n], up = acc[ai][1][m][n]; f32x4 hv;
#pragma unroll
                    for (int j = 0; j < 4; ++j) hv[j] = gt[j] * __builtin_amdgcn_rcpf(1.f + fast_exp2(gt[j] * -1.4426950408889634f)) * up[j];
                    *(h16x4*)(O + (size_t)row * FFH + u.pn * HALF + (cbase - u.col0) + n * CN) = cvt4(hv); }
            }
    } break;
    default: break;
    }
}

template <int EPI> __device__ __forceinline__ void gemm_run(LAS unsigned char* lds, const GemmDesc& g, unsigned char* ws) {
    const int tid = tid_here(), wid = __builtin_amdgcn_readfirstlane(tid >> 6), lane = tid & 63, wr = wid >> 2, wc = wid & 3, fr = lane & 15, fq = lane >> 4;
    LAS int* utab = (LAS int*)(lds + 131072 + 8192);
    if (tid < 32) { Unit u; const bool ok = unit_next(g, tid, gridDim.x, bid_here(), u);
        utab[tid * 8 + 0] = ok ? u.row0 : -1; utab[tid * 8 + 1] = u.col0; utab[tid * 8 + 2] = u.pn; utab[tid * 8 + 3] = (int)u.a; utab[tid * 8 + 4] = (int)u.b; }
    __syncthreads();
#define UT(i, f) __builtin_amdgcn_readfirstlane(utab[(i) * 8 + (f)])
    const int nt = g.K / BK;
    const char* const gA = (const char*)g.A; const char* const gB = (const char*)g.B;
    unsigned voffA[2], voffB[2];
#pragma unroll
    for (int i = 0; i < 2; ++i) { int R, C; stage_rc(tid * 16 + i * 8192, R, C); const int Rb = (R & ~31) + perm32(R & 31);
        voffA[i] = (unsigned)(R * g.lda + C) * 2u; voffB[i] = (unsigned)(Rb * g.ldb + C) * 2u; }
    const unsigned kstep = (unsigned)(BK * 2);
    const unsigned hstepA = (unsigned)HALF * g.lda * 2u, hstepB = (unsigned)HALF * g.ldb * 2u;
    const unsigned ldsw = (unsigned)wid * 1024u;
    const int aoff = lds_byte(wr * 64 + fr, fq * 8), boff = lds_byte(wc * 32 + fr, fq * 8);
#define SA(b, h) (((b) * 2 + (h)) * HTB)
#define SB(b, h) ((4 + (b) * 2 + (h)) * HTB)
#define STAGE(bufoff, gbase, soff, voff) do { _Pragma("unroll") for (int _i = 0; _i < 2; ++_i) \
        __builtin_amdgcn_global_load_lds((const unsigned*)((gbase) + (size_t)((soff) + (voff)[_i])), (LAS unsigned*)(lds + (bufoff) + ldsw + _i * 8192), 16, 0, 0); } while (0)
#define LDA(dst, b, h) do { _Pragma("unroll") for (int m = 0; m < 4; ++m) _Pragma("unroll") for (int k = 0; k < 2; ++k) dst[m][k] = *(const LAS h16x8*)(lds + SA(b, h) + aoff + m * 2048 + k * 1024); } while (0)
#define LDB(dst, b, h) do { _Pragma("unroll") for (int n = 0; n < 2; ++n) _Pragma("unroll") for (int k = 0; k < 2; ++k) dst[n][k] = *(const LAS h16x8*)(lds + SB(b, h) + boff + n * 2048 + k * 1024); } while (0)
#define MMA(ai, bj, At, Bt) do { __builtin_amdgcn_s_setprio(1); _Pragma("unroll") for (int m = 0; m < 4; ++m) _Pragma("unroll") for (int n = 0; n < 2; ++n) _Pragma("unroll") for (int k = 0; k < 2; ++k) \
        acc[ai][bj][m][n] = __builtin_amdgcn_mfma_f32_16x16x32_f16(Bt[n][k], At[m][k], acc[ai][bj][m][n], 0, 0, 0); __builtin_amdgcn_s_setprio(0); } while (0)
#define MMAZ(ai, bj, At, Bt) do { __builtin_amdgcn_s_setprio(1); _Pragma("unroll") for (int m = 0; m < 4; ++m) _Pragma("unroll") for (int n = 0; n < 2; ++n) { \
        acc[ai][bj][m][n] = __builtin_amdgcn_mfma_f32_16x16x32_f16(Bt[n][0], At[m][0], (f32x4){0.f, 0.f, 0.f, 0.f}, 0, 0, 0); \
        acc[ai][bj][m][n] = __builtin_amdgcn_mfma_f32_16x16x32_f16(Bt[n][1], At[m][1], acc[ai][bj][m][n], 0, 0, 0); } __builtin_amdgcn_s_setprio(0); } while (0)
#define WAIT_V(n) asm volatile("s_waitcnt vmcnt(" #n ")" ::: "memory")
#define WAIT_L(n) asm volatile("s_waitcnt lgkmcnt(" #n ")" ::: "memory")
#define BAR __builtin_amdgcn_s_barrier()
#define SCHED __builtin_amdgcn_sched_barrier(0)
    Unit cur; int ui = 0;
    cur.row0 = UT(0, 0);
    if (cur.row0 < 0) return;
    cur.col0 = UT(0, 1); cur.pn = UT(0, 2); cur.a = (unsigned)UT(0, 3); cur.b = (unsigned)UT(0, 4);
    f32x4 acc[2][2][4][2];
    h16x8 At[4][2], B0[2][2], B1[2][2];
    unsigned cA = cur.a, cB = cur.b;
    const bool use_ct = (EPI == E_RESID) || ((EPI == E_INPROJ || EPI == E_F16 || EPI == E_SWIGLU) && g.fold);
    const bool use_st = use_ct || EPI == E_QUP || EPI == E_KUP || EPI == E_VTUP;
    const float* const stsrc = (EPI == E_QUP || EPI == E_KUP || EPI == E_VTUP) ? (const float*)(ws + WS_SSQ) : g.st_in;
    const float* const ctA = (EPI == E_RESID) ? g.res : g.cs; const float* const ctB = (EPI == E_RESID) ? g.bias : g.cs + 2 * NCS;
#define STATS_DMA(r0, sel) __builtin_amdgcn_global_load_lds((const unsigned*)(stsrc + (size_t)((r0) + wid * 32 + (lane >> 1)) * 8 + (lane & 1) * 4), (LAS unsigned*)(lds + LDS_STATS + (sel) * 8192 + wid * 1024), 16, 0, 0)
#define COLS_DMA(c0, sel) __builtin_amdgcn_global_load_lds((const unsigned*)((wid == 0 ? ctA : ctB) + (c0) + lane * 4), (LAS unsigned*)(lds + LDS_COLS + (sel) * 2048 + wid * 1024), 16, 0, 0)
    if (use_st) STATS_DMA((EPI == E_VTUP) ? cur.col0 : cur.row0, 0);
    if (use_ct && wid < 2) COLS_DMA(cur.col0, 0);
    STAGE(SB(0, 0), gB, cB, voffB); STAGE(SB(0, 1), gB, cB + hstepB, voffB); STAGE(SA(0, 0), gA, cA, voffA); STAGE(SA(0, 1), gA, cA + hstepA, voffA);
    if (wr == 1) BAR;
    WAIT_V(2); BAR;
    STAGE(SB(1, 0), gB, cB + kstep, voffB); STAGE(SA(1, 0), gA, cA + kstep, voffA); STAGE(SB(1, 1), gB, cB + hstepB + kstep, voffB);
    WAIT_V(6); BAR;
    for (;;) {
        const int nrow0 = (ui + 1 < 32) ? UT(ui + 1, 0) : -1;
        const bool has_next = nrow0 >= 0;
        const unsigned nA = has_next ? (unsigned)UT(ui + 1, 3) : cA, nB = has_next ? (unsigned)UT(ui + 1, 4) : cB;
        { const int t = 0;
            const bool last = (t == nt - 2);
            const unsigned a1 = cA + (unsigned)(t + 1) * kstep;
            const unsigned a2 = last ? nA : cA + (unsigned)(t + 2) * kstep, b2 = last ? nB : cB + (unsigned)(t + 2) * kstep;
            const unsigned a3 = a2 + kstep, b3 = b2 + kstep;
            LDB(B0, 0, 0); LDB(B1, 0, 1); SCHED; LDA(At, 0, 0); STAGE(SA(1, 1), gA, a1 + hstepA, voffA);
            WAIT_V(8); WAIT_L(0); BAR; MMAZ(0, 0, At, B0); MMAZ(0, 1, At, B1); BAR; SCHED;
            LDA(At, 0, 1); STAGE(SB(0, 0), gB, b2, voffB); STAGE(SB(0, 1), gB, b2 + hstepB, voffB); STAGE(SA(0, 0), gA, a2, voffA);
            WAIT_V(8); WAIT_L(0); BAR; MMAZ(1, 0, At, B0); MMAZ(1, 1, At, B1); BAR; SCHED;
            LDB(B0, 1, 0); LDB(B1, 1, 1); SCHED; LDA(At, 1, 0); STAGE(SA(0, 1), gA, a2 + hstepA, voffA);
            WAIT_V(8); WAIT_L(0); BAR; MMA(0, 0, At, B0); MMA(0, 1, At, B1); BAR; SCHED;
            LDA(At, 1, 1); STAGE(SB(1, 0), gB, b3, voffB); STAGE(SB(1, 1), gB, b3 + hstepB, voffB); STAGE(SA(1, 0), gA, a3, voffA);
            WAIT_V(8); WAIT_L(0); BAR; MMA(1, 0, At, B0); MMA(1, 1, At, B1); BAR; SCHED;
        }
        for (int t = 2; t < nt; t += 2) {
            const bool last = (t == nt - 2);
            const unsigned a1 = cA + (unsigned)(t + 1) * kstep;
            const unsigned a2 = last ? nA : cA + (unsigned)(t + 2) * kstep, b2 = last ? nB : cB + (unsigned)(t + 2) * kstep;
            const unsigned a3 = a2 + kstep, b3 = b2 + kstep;
            LDB(B0, 0, 0); LDB(B1, 0, 1); SCHED; LDA(At, 0, 0); STAGE(SA(1, 1), gA, a1 + hstepA, voffA);
            WAIT_V(8); WAIT_L(0); BAR; MMA(0, 0, At, B0); MMA(0, 1, At, B1); BAR; SCHED;
            LDA(At, 0, 1); STAGE(SB(0, 0), gB, b2, voffB); STAGE(SB(0, 1), gB, b2 + hstepB, voffB); STAGE(SA(0, 0), gA, a2, voffA);
            WAIT_V(8); WAIT_L(0); BAR; MMA(1, 0, At, B0); MMA(1, 1, At, B1); BAR; SCHED;
            LDB(B0, 1, 0); LDB(B1, 1, 1); SCHED; LDA(At, 1, 0); STAGE(SA(0, 1), gA, a2 + hstepA, voffA);
            WAIT_V(8); WAIT_L(0); BAR; MMA(0, 0, At, B0); MMA(0, 1, At, B1); BAR; SCHED;
            LDA(At, 1, 1); STAGE(SB(1, 0), gB, b3, voffB); STAGE(SB(1, 1), gB, b3 + hstepB, voffB); STAGE(SA(1, 0), gA, a3, voffA);
            WAIT_V(8); WAIT_L(0); BAR; MMA(1, 0, At, B0); MMA(1, 1, At, B1); BAR; SCHED;
        }
        if (wr == 0) BAR;
        int fr_e = fr, fq_e = fq; asm volatile("" : "+v"(fr_e), "+v"(fq_e));
        epilogue<EPI>(g, cur, acc, wr, wc, fr_e, fq_e, lds, ws, (const LAS float*)(lds + LDS_STATS + (ui & 1) * 8192), (const LAS float*)(lds + LDS_COLS + (ui & 1) * 2048));
        if (has_next) { if (use_st) STATS_DMA((EPI == E_VTUP) ? UT(ui + 1, 1) : nrow0, (ui + 1) & 1); if (use_ct && wid < 2) COLS_DMA(UT(ui + 1, 1), (ui + 1) & 1); }
        if (!has_next) break;
        ++ui;
        cur.row0 = nrow0; cur.col0 = UT(ui, 1); cur.pn = UT(ui, 2); cur.a = nA; cur.b = nB; cA = nA; cB = nB;
        if (wr == 1) BAR;
    }
    WAIT_V(0);
    BAR;
#undef STATS_DMA
#undef COLS_DMA
#undef UT
#undef SA
#undef SB
#undef STAGE
#undef LDA
#undef LDB
#undef MMA
#undef MMAZ
#undef WAIT_V
#undef WAIT_L
#undef BAR
#undef SCHED
}

__device__ const double INV_FREQ[16] = {1.0, 0.5623413251903491, 0.31622776601683794, 0.1778279410038923, 0.1, 0.05623413251903491, 0.03162277660168379,
    0.01778279410038923, 0.01, 0.005623413251903491, 0.0031622776601683794, 0.0017782794100389228, 0.001, 0.0005623413251903491, 0.00031622776601683794, 0.00017782794100389227};

__device__ __forceinline__ void transpose_item(const float* W, int K, int N, h16* WT, int drow, bool rperm, const float* kscale, const float* kbias, float* part, LAS float* scr, int k0, int n0, int lane) {
    { float wv[32];
#pragma unroll
      for (int i = 0; i < 32; ++i) wv[i] = W[(size_t)(k0 + 2 * i + (lane >> 5)) * N + n0 + (lane & 31)];
#pragma unroll
      for (int i = 0; i < 32; ++i) scr[(2 * i + (lane >> 5)) * 33 + (lane & 31)] = wv[i]; }
    asm volatile("s_waitcnt lgkmcnt(0)" ::: "memory");
    const int c = lane & 7;
    float sc[8];
#pragma unroll
    for (int e = 0; e < 8; ++e) sc[e] = kscale ? kscale[k0 + 8 * c + e] : 1.f;
#pragma unroll
    for (int j = 0; j < 4; ++j) { const int n = (lane >> 3) + 8 * j; const LAS float* s = scr + (8 * c) * 33 + n;
        h16x8 o;
#pragma unroll
        for (int e = 0; e < 8; ++e) o[e] = (h16)(s[e * 33] * sc[e]);
        *(h16x8*)(WT + (size_t)(drow + (rperm ? perm32(n) : n)) * K + k0 + 8 * c) = o; }
    if (part) {
        const float myks = kscale[k0 + lane], mykb = kbias[k0 + lane];
        float a = 0.f, b = 0.f; const int n = lane & 31, kh = (lane >> 5) * 32;
#pragma unroll
        for (int kk = 0; kk < 32; ++kk) { const float w = scr[(kh + kk) * 33 + n];
            a += w * __shfl(myks, kh + kk); b += w * __shfl(mykb, kh + kk); }
        a += __shfl_xor(a, 32); b += __shfl_xor(b, 32);
        if (lane < 32) *(f32x2*)(part + ((size_t)(drow + (rperm ? perm32(lane) : lane)) * 16 + (k0 >> 6)) * 2) = (f32x2){a, b};
    }
    asm volatile("s_waitcnt lgkmcnt(0)" ::: "memory");
}

__device__ __forceinline__ void prologue(LAS unsigned char* lds, KP P) {
    const int tid = tid_here(), lane = tid & 63, wave = tid >> 6, bid = bid_here();
    const int G = gridDim.x, gw = bid * 8 + wave, NGW = G * 8;
    const long gt = (long)bid * 512 + tid, NGT = (long)G * 512;
    LAS float* scr = (LAS float*)(lds + wave * 16384);
    constexpr int NJ = 9;
    const int jK[NJ] = {1024, 256, 256, 1024, 1024, 1024, 1024, 1024, 2816};
    const int jN[NJ] = {1568, 768, 1024, 1024, 1024, 2048, 1024, 5632, 1024};
    const int jin[NJ] = {3, 6, 8, 13, 16, 17, 18, 21, 22};
    const size_t jdst[NJ] = {WO_WIN, WO_WUQ, WO_WUK, WO_WO, WO_XWQ, WO_XWKV, WO_XWO, WO_FWIN, WO_FWD};
    int items_per_layer = 0;
#pragma unroll
    for (int j = 0; j < NJ; ++j) items_per_layer += (jK[j] / 64) * (jN[j] / 32);
    for (int it = gw; it < 2 * items_per_layer; it += NGW) {
        const int l = it / items_per_layer; int r = it % items_per_layer; int j = 0;
#pragma unroll
        for (int jj = 0; jj < NJ - 1; ++jj) { const int cnt = (jK[jj] / 64) * (jN[jj] / 32); if (j == jj && r >= cnt) { r -= cnt; j = jj + 1; } }
        int K = 0, N = 0, ini = 0; size_t dsto = 0;
#pragma unroll
        for (int jj = 0; jj < NJ; ++jj) if (j == jj) { K = jK[jj]; N = jN[jj]; ini = jin[jj]; dsto = jdst[jj]; }
        const int nblk = N / 32, kb = r / nblk, nb = r % nblk, n0 = nb * 32;
        int drow = n0; const float* ks = nullptr; const float* kbs = nullptr; float* part = nullptr; bool rperm = false;
        float* partl = (float*)(P->ws + WS_PART) + (size_t)l * NCS * 32;
        if (j == 0) { drow = n0 < 512 ? n0 : (n0 < 544 ? 1536 + (n0 - 512) : n0 - 32); rperm = (n0 == 512); if (l > 0) { ks = P->in[23] + (l - 1) * DM; kbs = P->in[24] + (l - 1) * DM; part = partl; } }
        else if (j == 4) { ks = P->in[14] + l * DM; kbs = P->in[15] + l * DM; part = partl + (size_t)1792 * 32; }
        else if (j == 1) { ks = P->in[5] + l * 256; rperm = (nb % 3 == 2); }
        else if (j == 2) { const int h = nb >> 2, part = nb & 3; drow = part < 2 ? h * 64 + 32 * part : 512 + h * 64 + 32 * (part - 2); ks = P->in[7] + l * 256; }
        else if (j == 7) { const int jj = n0 < FFH ? n0 : n0 - FFH; drow = (jj >> 7) * 256 + (jj & 127) + (n0 < FFH ? 0 : 128); ks = P->in[19] + l * DM; kbs = P->in[20] + l * DM; part = partl + (size_t)(1792 + 1024) * 32; }
        transpose_item(P->in[ini] + (size_t)l * K * N, K, N, (h16*)(P->ws + WS_W + (size_t)l * 32 * MiB) + dsto, drow, rperm, ks, kbs, part, scr, kb * 64, n0, lane);
    }
    for (long i = gt; i < 2L * 224 * 1024 / 8; i += NGT) { const int l = (int)(i / (224 * 1024 / 8)); const long r = i % (224 * 1024 / 8);
        unsigned zz = 0; asm volatile("" : "+v"(zz));
        *(u32x4*)((h16*)(P->ws + WS_W + (size_t)l * 32 * MiB) + WO_WIN + (size_t)1568 * 1024 + r * 8) = (u32x4){zz, zz, zz, zz}; }
    for (long i = gt; i < 2 * 1792; i += NGT) { const int l = (int)(i / 1792), r = (int)(i % 1792);
        const int src = r < 512 ? r : (r < 1536 ? r + 32 : (r < 1568 ? 512 + (r - 1536) : -1));
        ((float*)(P->ws + WS_BIAS))[i] = src >= 0 ? P->in[4][l * 1568 + src] : 0.f; }
    for (long i = gt; i < (long)TT * 16; i += NGT) { const int tok = (int)(i >> 4), f = (int)(i & 15);
        const double ang = (double)P->pos[tok] * INV_FREQ[f];
        const double kq = __builtin_rint(ang * 0.6366197723675814); const double r = (ang - kq * 1.5707963267948966) - kq * 6.123233995736766e-17;
        const double r2 = r * r;
        const double sn = r * (1.0 + r2 * (-1.0 / 6 + r2 * (1.0 / 120 + r2 * (-1.0 / 5040 + r2 * (1.0 / 362880 + r2 * (-1.0 / 39916800))))));
        const double cs = 1.0 + r2 * (-0.5 + r2 * (1.0 / 24 + r2 * (-1.0 / 720 + r2 * (1.0 / 40320 + r2 * (-1.0 / 3628800 + r2 * (1.0 / 479001600))))));
        const int q = (int)((long long)kq & 3);
        const double c = q == 0 ? cs : (q == 1 ? -sn : (q == 2 ? -cs : sn));
        const double s = q == 0 ? sn : (q == 1 ? cs : (q == 2 ? -sn : -cs));
        ((float*)(P->ws + WS_COS))[i] = (float)c; ((float*)(P->ws + WS_SIN))[i] = (float)s; }
    {
        const long n8x = (long)TT * DM / 8, n8m = (long)MEMT * DM / 8;
        for (int pass = 0; pass < 2; ++pass) {
            const f32x4* src = (const f32x4*)(pass == 0 ? P->in[0] : P->in[1]); h16x8* dst = (h16x8*)(P->ws + (pass == 0 ? WS_XH : WS_MEMH)); const long n8 = pass == 0 ? n8x : n8m;
            for (long i = gt; i < n8; i += 4 * NGT) {
                f32x4 a[4], b[4];
#pragma unroll
                for (int q = 0; q < 4; ++q) { const long ii = i + q * NGT; if (ii < n8) { a[q] = src[2 * ii]; b[q] = src[2 * ii + 1]; } }
#pragma unroll
                for (int q = 0; q < 4; ++q) { const long ii = i + q * NGT; if (ii < n8) { h16x8 o; o[0] = (h16)a[q][0]; o[1] = (h16)a[q][1]; o[2] = (h16)a[q][2]; o[3] = (h16)a[q][3]; o[4] = (h16)b[q][0]; o[5] = (h16)b[q][1]; o[6] = (h16)b[q][2]; o[7] = (h16)b[q][3]; dst[ii] = o; } }
            }
        }
    }
}

__device__ __forceinline__ void csbw_finalize(KP P) {
    const long gt = (long)bid_here() * 512 + tid_here(), NGT = (long)gridDim.x * 512;
    const float* part = (const float*)(P->ws + WS_PART); float* cs = (float*)(P->ws + WS_CSBW);
    for (long i = gt; i < 2L * NCS; i += NGT) { const int c = (int)(i % NCS); float a = 0.f, b = 0.f;
        if (!(c >= 1568 && c < 1792) && !(i < 1792)) {
            const f32x2* p = (const f32x2*)part + i * 16;
#pragma unroll
            for (int k = 0; k < 16; ++k) { const f32x2 v = p[k]; a += v[0]; b += v[1]; } }
        cs[i] = a; cs[2 * NCS + i] = b; }
}
__device__ __forceinline__ void ln_final(KP P, const float* gam, const float* bet) {
    const int tid = tid_here(), lane = tid & 63, wave = tid >> 6;
    const int gw = bid_here() * 8 + wave, NGW = gridDim.x * 8;
    f32x4 gv[4], bv[4];
#pragma unroll
    for (int j = 0; j < 2; ++j) { gv[2 * j] = ((const f32x4*)gam)[128 * j + 2 * lane]; gv[2 * j + 1] = ((const f32x4*)gam)[128 * j + 2 * lane + 1];
                                  bv[2 * j] = ((const f32x4*)bet)[128 * j + 2 * lane]; bv[2 * j + 1] = ((const f32x4*)bet)[128 * j + 2 * lane + 1]; }
    h16x8 z[2][2], zn[2][2];
#define LN_LOAD(dst, r0) do { _Pragma("unroll") for (int r = 0; r < 2; ++r) _Pragma("unroll") for (int j = 0; j < 2; ++j) \
        dst[r][j] = ((const h16x8*)((const h16*)(P->ws + WS_XH) + (size_t)((r0) + r) * DM))[64 * j + lane]; } while (0)
    if (gw * 2 < TT) LN_LOAD(z, gw * 2);
    for (int row0 = gw * 2; row0 < TT; row0 += NGW * 2) {
        const bool more = row0 + NGW * 2 < TT;
        if (more) LN_LOAD(zn, row0 + NGW * 2);
#pragma unroll
        for (int r = 0; r < 2; ++r) {
            f32x4 v[4]; float s = 0.f;
#pragma unroll
            for (int j = 0; j < 2; ++j) { v[2 * j] = (f32x4){(float)z[r][j][0], (float)z[r][j][1], (float)z[r][j][2], (float)z[r][j][3]}; v[2 * j + 1] = (f32x4){(float)z[r][j][4], (float)z[r][j][5], (float)z[r][j][6], (float)z[r][j][7]}; }
#pragma unroll
            for (int j = 0; j < 4; ++j) s += (v[j][0] + v[j][1]) + (v[j][2] + v[j][3]);
            const float mean = wave_sum(s) * (1.f / DM); float s2 = 0.f;
#pragma unroll
            for (int j = 0; j < 4; ++j) { v[j] = v[j] - mean; s2 += (v[j][0] * v[j][0] + v[j][1] * v[j][1]) + (v[j][2] * v[j][2] + v[j][3] * v[j][3]); }
            const float rstd = 1.f / sqrtf(wave_sum(s2) * (1.f / DM) + 1e-5f);
            f32x4* xr = (f32x4*)(P->out + (size_t)(row0 + r) * DM);
#pragma unroll
            for (int j = 0; j < 2; ++j) { xr[128 * j + 2 * lane] = v[2 * j] * rstd * gv[2 * j] + bv[2 * j]; xr[128 * j + 2 * lane + 1] = v[2 * j + 1] * rstd * gv[2 * j + 1] + bv[2 * j + 1]; }
        }
        if (more) {
#pragma unroll
            for (int r = 0; r < 2; ++r)
#pragma unroll
                for (int j = 0; j < 2; ++j) z[r][j] = zn[r][j]; }
    }
#undef LN_LOAD
}

__device__ __forceinline__ void conv_phase(LAS unsigned char* lds, KP P, int l) {
    const int tid = tid_here(), lane = tid & 63, wave = tid >> 6;
    const h16* PROJ = (const h16*)(P->ws + WS_PROJ); h16* YC = (h16*)(P->ws + WS_YCAT);
    LAS unsigned* hp = (LAS unsigned*)lds;
    LAS float* cb = (LAS float*)(lds + 65536);
    h16x2 wE[16], wO[16];
    { float w[31];
#pragma unroll
      for (int j = 0; j < 31; ++j) w[j] = P->in[9][(size_t)l * 31 * 512 + j * 512 + tid];
#pragma unroll
      for (int i = 0; i < 15; ++i) { wE[i] = (h16x2){(h16)w[2 * i], (h16)w[2 * i + 1]}; wO[i + 1] = (h16x2){(h16)w[2 * i + 1], (h16)w[2 * i + 2]}; }
      wE[15] = (h16x2){(h16)w[30], (h16)0.f}; wO[0] = (h16x2){(h16)0.f, (h16)w[0]}; }
    const float bias = P->in[10][l * 512 + tid];
    f32x4 ng[2], nbv[2];
#pragma unroll
    for (int j = 0; j < 2; ++j) { ng[j] = *(const f32x4*)(P->in[11] + l * 512 + lane * 8 + 4 * j); nbv[j] = *(const f32x4*)(P->in[12] + l * 512 + lane * 8 + 4 * j); }
    h16x8 ra0[4], rg0[4], ra1[4], rg1[4];
#define CONV_LOAD(uu) do { const int b_ = (uu) >> 6, t0_ = ((uu) & 63) * 32; \
        _Pragma("unroll") for (int k_ = 0; k_ < 4; ++k_) { const int idx_ = tid + 512 * k_; const int pr_ = idx_ >> 6, c8_ = idx_ & 63, tok_ = t0_ - 30 + 2 * pr_; \
            if (idx_ < 31 * 64 && tok_ >= 0) { const h16* src_ = PROJ + (size_t)(b_ * SEQ + tok_) * PROJW + 512 + c8_ * 8; \
                ra0[k_] = *(const h16x8*)src_; rg0[k_] = *(const h16x8*)(src_ + 512); ra1[k_] = *(const h16x8*)(src_ + PROJW); rg1[k_] = *(const h16x8*)(src_ + PROJW + 512); } } } while (0)
#define CONV_GLU(uu) do { const int t0_ = ((uu) & 63) * 32; \
        _Pragma("unroll") for (int k_ = 0; k_ < 4; ++k_) { const int idx_ = tid + 512 * k_; const int pr_ = idx_ >> 6, c8_ = idx_ & 63, tok_ = t0_ - 30 + 2 * pr_; \
            if (idx_ < 31 * 64) { u32x4 d0_ = {0u, 0u, 0u, 0u}, d1_ = {0u, 0u, 0u, 0u}; \
                if (tok_ >= 0) { \
                    _Pragma("unroll") for (int e = 0; e < 8; ++e) { \
                        const float h0_ = (float)ra0[k_][e] * __builtin_amdgcn_rcpf(1.f + fast_exp2((float)rg0[k_][e] * -1.4426950408889634f)); \
                        const float h1_ = (float)ra1[k_][e] * __builtin_amdgcn_rcpf(1.f + fast_exp2((float)rg1[k_][e] * -1.4426950408889634f)); \
                        const h16x2 pk_ = {(h16)h0_, (h16)h1_}; const unsigned w_ = __builtin_bit_cast(unsigned, pk_); \
                        if (e < 4) d0_[e] = w_; else d1_[e - 4] = w_; } } \
                *(LAS u32x4*)(hp + pr_ * 512 + c8_ * 8) = d0_; *(LAS u32x4*)(hp + pr_ * 512 + c8_ * 8 + 4) = d1_; } } } while (0)
    const int u_first = bid_here();
    if (u_first < TT / 32) { CONV_LOAD(u_first); CONV_GLU(u_first); }
    LDS_BARRIER();
    for (int u = u_first; u < TT / 32; u += gridDim.x) {
        const int b = u >> 6, t0 = (u & 63) * 32;
        const int un = u + gridDim.x; const bool has_next = un < TT / 32;
        if (has_next) CONV_LOAD(un);
        for (int m = 0; m < 16; ++m) {
            float a0 = bias, a1 = bias;
#pragma unroll
            for (int i = 0; i < 16; ++i) { const h16x2 p = __builtin_bit_cast(h16x2, hp[(m + i) * 512 + tid]);
                a0 = __builtin_amdgcn_fdot2(p, wE[i], a0, false); a1 = __builtin_amdgcn_fdot2(p, wO[i], a1, false); }
            cb[(2 * m) * 512 + tid] = a0; cb[(2 * m + 1) * 512 + tid] = a1;
        }
        LDS_BARRIER();
        if (has_next) CONV_GLU(un);
#pragma unroll
        for (int k = 0; k < 4; ++k) {
            const int lt = wave * 4 + k;
            f32x4 v0 = *(const LAS f32x4*)(cb + lt * 512 + lane * 8), v1 = *(const LAS f32x4*)(cb + lt * 512 + lane * 8 + 4);
            const float mean = wave_sum((v0[0] + v0[1]) + (v0[2] + v0[3]) + (v1[0] + v1[1]) + (v1[2] + v1[3])) * (1.f / 512.f);
            v0 = v0 - mean; v1 = v1 - mean;
            const float var = wave_sum((v0[0] * v0[0] + v0[1] * v0[1]) + (v0[2] * v0[2] + v0[3] * v0[3]) + (v1[0] * v1[0] + v1[1] * v1[1]) + (v1[2] * v1[2] + v1[3] * v1[3])) * (1.f / 512.f);
            const float rstd = 1.f / sqrtf(var + 1e-5f);
            v0 = v0 * rstd * ng[0] + nbv[0]; v1 = v1 * rstd * ng[1] + nbv[1];
            h16x8 o;
#pragma unroll
            for (int e = 0; e < 4; ++e) { o[e] = (h16)(v0[e] * __builtin_amdgcn_rcpf(1.f + fast_exp2(v0[e] * -1.4426950408889634f))); o[4 + e] = (h16)(v1[e] * __builtin_amdgcn_rcpf(1.f + fast_exp2(v1[e] * -1.4426950408889634f))); }
            *(h16x8*)(YC + (size_t)(b * SEQ + t0 + lt) * DM + 512 + lane * 8) = o;
        }
        LDS_BARRIER();
    }
#undef CONV_LOAD
#undef CONV_GLU
}

constexpr int KPITCH = 208, VPITCH = 264;
__device__ __forceinline__ void attn_phase(LAS unsigned char* lds, KP P) {
    const int tid = tid_here(), lane = tid & 63, r32 = lane & 31, hi = lane >> 5; const int wid = __builtin_amdgcn_readfirstlane(tid >> 6);
    const h16* Q = (const h16*)(P->ws + WS_Q); const h16* KN = (const h16*)(P->ws + WS_KN); const h16* KR = (const h16*)(P->ws + WS_KR);
    const h16* VT = (const h16*)(P->ws + WS_VT); h16* YC = (h16*)(P->ws + WS_YCAT);
    LAS unsigned char* Kb = lds; LAS unsigned char* Vb = lds + 2 * 128 * KPITCH; LAS unsigned char* Sg = lds + 2 * 128 * KPITCH + 2 * 64 * VPITCH + wid * (32 * 144);
    u32x4 sk[3], sv[2];
#define LOADT(J, rowbase_, h_) do { const size_t kb_ = (rowbase_) + 128 * (J); \
        _Pragma("unroll") for (int i_ = 0; i_ < 3; ++i_) { const int c_ = tid + 512 * i_, kr_ = c_ / 12, kc_ = c_ % 12; \
            sk[i_] = kc_ < 8 ? *(const u32x4*)(KN + (kb_ + kr_) * 512 + (h_) * 64 + kc_ * 8) : *(const u32x4*)(KR + (kb_ + kr_) * 32 + (kc_ - 8) * 8); } \
        _Pragma("unroll") for (int i_ = 0; i_ < 2; ++i_) { const int c_ = tid + 512 * i_; \
            sv[i_] = *(const u32x4*)(VT + (size_t)((h_) * 64 + (c_ >> 4)) * TT + kb_ + (c_ & 15) * 8); } } while (0)
#define STORET(buf) do { \
        _Pragma("unroll") for (int i_ = 0; i_ < 3; ++i_) { const int c_ = tid + 512 * i_, kr_ = c_ / 12, kc_ = c_ % 12; \
            *(LAS u32x4*)(Kb + (buf) * 128 * KPITCH + kr_ * KPITCH + kc_ * 16) = sk[i_]; } \
        _Pragma("unroll") for (int i_ = 0; i_ < 2; ++i_) { const int c_ = tid + 512 * i_; LAS unsigned char* vd_ = Vb + (buf) * 64 * VPITCH + (c_ >> 4) * VPITCH + (c_ & 15) * 16; \
            *(LAS unsigned long long*)vd_ = ((unsigned long long)sv[i_][1] << 32) | sv[i_][0]; \
            *(LAS unsigned long long*)(vd_ + 8) = ((unsigned long long)sv[i_][3] << 32) | sv[i_][2]; } } while (0)
#define LOADQ(dst, u_) do { const int bh_ = (u_) & 255, qb_ = 7 - ((u_) >> 8); \
        const h16* qp_ = Q + ((size_t)(bh_ >> 3) * SEQ + qb_ * 256 + wid * 32 + r32) * 768 + (bh_ & 7) * 96 + 8 * hi; \
        _Pragma("unroll") for (int d0 = 0; d0 < 6; ++d0) dst[d0] = *(const h16x8*)(qp_ + 16 * d0); } while (0)
    h16x8 qf[6];
    const int u_first = bid_here();
    if (u_first < 2048) { LOADQ(qf, u_first); LOADT(0, (size_t)((u_first & 255) >> 3) * SEQ, (u_first & 255) & 7); STORET(0); }
    LDS_BARRIER();
    for (int u = u_first; u < 2048; u += gridDim.x) {
        const int bh = u & 255, qb = 7 - (u >> 8), b = bh >> 3, h = bh & 7;
        const size_t rowbase = (size_t)b * SEQ; const int q0 = qb * 256, NT2 = 2 * qb + 2, my_last = 4 * qb + (wid >> 1);
        const int un = u + gridDim.x; const bool has_next = un < 2048;
        const size_t rowbase_n = (size_t)((un & 255) >> 3) * SEQ; const int h_n = (un & 255) & 7;
        f32x16 o0, o1; float m_run = -INFINITY, lsum = 0.f;
#pragma unroll
        for (int r = 0; r < 16; ++r) { o0[r] = 0.f; o1[r] = 0.f; }
        auto compute = [&](const LAS unsigned char* kbase, const LAS unsigned char* vbase) {
                f32x16 p0, p1;
                const LAS unsigned char* kp = kbase + r32 * KPITCH + hi * 16;
                const LAS unsigned char* vp = vbase + r32 * VPITCH + hi * 8;
                h16x8 kf[12];
#pragma unroll
                for (int d0 = 0; d0 < 6; ++d0) { kf[2 * d0] = *(const LAS h16x8*)(kp + d0 * 32); kf[2 * d0 + 1] = *(const LAS h16x8*)(kp + 32 * KPITCH + d0 * 32); }
                __builtin_amdgcn_sched_barrier(0);
#pragma unroll
                for (int d0 = 0; d0 < 6; ++d0) {
                    if (d0 == 0) { const f32x16 z16 = {0.f, 0.f, 0.f, 0.f, 0.f, 0.f, 0.f, 0.f, 0.f, 0.f, 0.f, 0.f, 0.f, 0.f, 0.f, 0.f};
                        p0 = __builtin_amdgcn_mfma_f32_32x32x16_f16(kf[0], qf[0], z16, 0, 0, 0); p1 = __builtin_amdgcn_mfma_f32_32x32x16_f16(kf[1], qf[0], z16, 0, 0, 0); }
                    else { p0 = __builtin_amdgcn_mfma_f32_32x32x16_f16(kf[2 * d0], qf[d0], p0, 0, 0, 0);
                    p1 = __builtin_amdgcn_mfma_f32_32x32x16_f16(kf[2 * d0 + 1], qf[d0], p1, 0, 0, 0); }
                }
                h16x4 vf[4][4];
#pragma unroll
                for (int t = 0; t < 4; ++t) { const int kbyte = (32 * (t >> 1) + 16 * (t & 1)) * 2;
                    vf[t][0] = *(const LAS h16x4*)(vp + kbyte); vf[t][1] = *(const LAS h16x4*)(vp + kbyte + 16);
                    vf[t][2] = *(const LAS h16x4*)(vp + 32 * VPITCH + kbyte); vf[t][3] = *(const LAS h16x4*)(vp + 32 * VPITCH + kbyte + 16); }
                __builtin_amdgcn_sched_barrier(0);
                float mx = __builtin_fmaxf(p0[0], p1[0]);
#pragma unroll
                for (int r = 1; r < 16; ++r) mx = __builtin_fmaxf(__builtin_fmaxf(mx, p0[r]), p1[r]);
                mx = fmaxf(mx, __shfl_xor(mx, 32));
                const float m_new = fmaxf(m_run, mx), alpha = fast_exp2(m_run - m_new); m_run = m_new;
                float ps = 0.f;
#pragma unroll
                for (int r = 0; r < 16; ++r) { p0[r] = fast_exp2(p0[r] - m_new); p1[r] = fast_exp2(p1[r] - m_new); ps += p0[r] + p1[r]; }
                lsum = lsum * alpha + ps;
#pragma unroll
                for (int r = 0; r < 16; ++r) { o0[r] *= alpha; o1[r] *= alpha; }
                h16x8 pb[4];
#pragma unroll
                for (int e = 0; e < 8; ++e) { pb[0][e] = (h16)p0[e]; pb[1][e] = (h16)p0[8 + e]; pb[2][e] = (h16)p1[e]; pb[3][e] = (h16)p1[8 + e]; }
#pragma unroll
                for (int t = 0; t < 4; ++t) {
                    const h16x8 va = {vf[t][0][0], vf[t][0][1], vf[t][0][2], vf[t][0][3], vf[t][1][0], vf[t][1][1], vf[t][1][2], vf[t][1][3]};
                    const h16x8 vc2 = {vf[t][2][0], vf[t][2][1], vf[t][2][2], vf[t][2][3], vf[t][3][0], vf[t][3][1], vf[t][3][2], vf[t][3][3]};
                    o0 = __builtin_amdgcn_mfma_f32_32x32x16_f16(va, pb[t], o0, 0, 0, 0);
                    o1 = __builtin_amdgcn_mfma_f32_32x32x16_f16(vc2, pb[t], o1, 0, 0, 0);
                }
        };
        for (int J = 0; J < NT2; ++J) {
            const int buf = J & 1;
            if (J + 1 < NT2) LOADT(J + 1, rowbase, h);
            else if (has_next) LOADT(0, rowbase_n, h_n);
            if (2 * J <= my_last) compute(Kb + buf * 128 * KPITCH, Vb + buf * 64 * VPITCH);
            if (2 * J + 1 <= my_last) compute(Kb + buf * 128 * KPITCH + 64 * KPITCH, Vb + buf * 64 * VPITCH + 128);
            if (J + 1 == NT2 && has_next) LOADQ(qf, un);
            if (J + 1 < NT2 || has_next) STORET(buf ^ 1);
            LDS_BARRIER();
        }
        lsum += __shfl_xor(lsum, 32);
        const float inv = 1.f / lsum;
        LAS h16* sg = (LAS h16*)Sg;
#pragma unroll
        for (int r = 0; r < 16; ++r) { const int d = (r & 3) + 8 * (r >> 2) + 4 * hi; sg[r32 * 72 + d] = (h16)(o0[r] * inv); sg[r32 * 72 + 32 + d] = (h16)(o1[r] * inv); }
        asm volatile("s_waitcnt lgkmcnt(0)" ::: "memory");
#pragma unroll
        for (int i = 0; i < 4; ++i) { const int id = i * 64 + lane, row = id >> 3, c = id & 7;
            const u32x4 v = *(const LAS u32x4*)(Sg + row * 144 + c * 16);
            *(u32x4*)(YC + (rowbase + q0 + wid * 32 + row) * DM + h * 64 + c * 8) = v; }
        asm volatile("s_waitcnt lgkmcnt(0)" ::: "memory");
    }
#undef LOADT
#undef STORET
#undef LOADQ
}


#define XB_TMO      128
#define XB_XCNT(j)  (256  + 64 * (j))
#define XB_XSUB(j)  (1280 + 64 * (j))
#define XB_XGEN(j)  (2304 + 64 * (j))
#define XB_TOP      3328
#define XB_TOPGEN   3392
#define XCD_BAR_WORDS 3456
#define XB_SPIN_CAP (1u << 18)
__device__ __forceinline__ unsigned xb_ld(unsigned* p)              { return __hip_atomic_load(p, __ATOMIC_RELAXED, __HIP_MEMORY_SCOPE_AGENT); }
__device__ __forceinline__ unsigned xb_add(unsigned* p, unsigned v) { return __hip_atomic_fetch_add(p, v, __ATOMIC_RELAXED, __HIP_MEMORY_SCOPE_AGENT); }
__device__ __forceinline__ unsigned xb_xcc_id() { return (unsigned)__builtin_amdgcn_s_getreg((3 << 11) | 20) & 0xFu; }
#define XB_SPIN(cond, bar) do { unsigned _sp = 0; while (cond) { __builtin_amdgcn_s_sleep(1); \
    if ((++_sp & 255u) == 0u) { if (xb_ld(&(bar)[XB_TMO])) break; if (_sp > XB_SPIN_CAP) { atomicAdd(&(bar)[XB_TMO], 1u); break; } } } } while (0)
struct XcdBarrier { unsigned* bar; unsigned x; volatile LAS unsigned* st; };
__device__ __forceinline__ XcdBarrier xcd_barrier_post(unsigned* bar, volatile LAS unsigned* st) {
    XcdBarrier b; b.bar = bar; b.x = xb_xcc_id(); b.st = st;
    if (threadIdx.x == 0) (void)xb_add(&bar[XB_XCNT(b.x)], 1u);
    return b;
}
__device__ __forceinline__ void xcd_barrier_complete(unsigned* bar, unsigned x, unsigned& nloc, unsigned& nx) {
    const unsigned G = gridDim.x * gridDim.y * gridDim.z;
    unsigned sum, cnt, mine, sp = 0u;
    for (;;) {
        sum = 0u; cnt = 0u; mine = 0u;
#pragma unroll
        for (unsigned j = 0; j < 16; ++j) { const unsigned c = xb_ld(&bar[XB_XCNT(j)]); sum += c; cnt += (c > 0u) ? 1u : 0u; mine = (j == x) ? c : mine; }
        if (sum == G) break;
        __builtin_amdgcn_s_sleep(1);
        if ((++sp & 255u) == 0u) { if (xb_ld(&bar[XB_TMO])) break; if (sp > XB_SPIN_CAP) { atomicAdd(&bar[XB_TMO], 1u); break; } }
    }
    nloc = mine > 0u ? mine : 1u; nx = cnt > 0u ? cnt : 1u;
}
__device__ __forceinline__ void xcd_barrier(const XcdBarrier& b) {
    asm volatile("s_waitcnt vmcnt(0)" ::: "memory");
    __syncthreads();
    if (threadIdx.x == 0) {
        unsigned* bar = (unsigned*)(kparams()->ws + WS_BAR); asm volatile("" : "+v"(bar));
        __builtin_amdgcn_s_waitcnt(0);
        unsigned nloc = b.st[0], nx = b.st[1];
        if (nloc == 0u) { xcd_barrier_complete(bar, b.x, nloc, nx); b.st[0] = nloc; b.st[1] = nx; }
        const unsigned old = xb_add(&bar[XB_XSUB(b.x)], 1u);
        const unsigned gen = old / nloc;
        if (old + 1u == (gen + 1u) * nloc) {
            __builtin_amdgcn_fence(__ATOMIC_RELEASE, "agent");
            asm volatile("s_waitcnt vmcnt(0)" ::: "memory");
            const unsigned og = xb_add(&bar[XB_TOP], 1u);
            const unsigned tg = og / nx;
            if (og + 1u == (tg + 1u) * nx) xb_add(&bar[XB_TOPGEN], 1u);
            else XB_SPIN(xb_ld(&bar[XB_TOPGEN]) == tg, bar);
            __builtin_amdgcn_fence(__ATOMIC_ACQUIRE, "agent");
            xb_add(&bar[XB_XGEN(b.x)], 1u);
            asm volatile("s_waitcnt vmcnt(0)" ::: "memory");
        } else {
            XB_SPIN(xb_ld(&bar[XB_XGEN(b.x)]) == gen, bar);
            __builtin_amdgcn_fence(__ATOMIC_ACQUIRE, "agent");
            asm volatile("s_waitcnt vmcnt(0)" ::: "memory");
        }
    }
    __syncthreads();
}

struct GT { unsigned long long a, b, o; int lda, ldb, K, nM, nN, nZ1, nZ2, a_s1, a_s2, b_s1, b_s2, epi, ldc, rkind, bias, fold, st_in, st_out, cs, gidx, gl; float scale; int ph; };
__device__ const GT GTAB[] = {
    {WS_MEMH, WS_W + 0ull * 32 * MiB + WO_XWKV * 2, WS_XK, 1024, 1024, 1024, 32, 4, 1, 2, 0, 0, 0, 16777216, E_F16, 2048, 0, -1, 0, 0, 0, 0, 0, 0, 1.f, 1},
    {WS_W + 0ull * 32 * MiB + (WO_XWKV + 1024 * 1024) * 2, WS_MEMH, WS_XVT, 1024, 1024, 1024, 4, 32, 2, 1, 16777216, 0, 0, 0, E_F16, MEMT, 0, -1, 0, 0, 0, 0, 0, 0, 1.f, 1},
    {WS_XH, WS_W + 0ull * 32 * MiB + WO_WIN * 2, WS_PROJ, 1024, 1024, 1024, 256, 7, 1, 1, 0, 0, 0, 0, E_INPROJ, 0, 0, (int)WS_BIAS, 0, 0, 0, 0, 0, 0, 1.f, 1},
    {WS_PROJ, WS_W + 0ull * 32 * MiB + WO_WUQ * 2, WS_Q, PROJW, 256, 256, 256, 3, 1, 1, 0, 0, 0, 0, E_QUP, 0, 0, -1, 0, 0, 0, 0, 0, 0, 1.f, 3},
    {WS_PROJ + 512, WS_W + 0ull * 32 * MiB + WO_WUK * 2, WS_KN, PROJW, 256, 256, 256, 2, 1, 1, 0, 0, 0, 0, E_KUP, 0, 0, -1, 0, 0, 0, 0, 0, 0, 1.f, 3},
    {WS_W + 0ull * 32 * MiB + WO_WUV * 2, WS_PROJ + 512, WS_VT, 256, PROJW, 256, 2, 256, 1, 1, 0, 0, 0, 0, E_VTUP, 0, 0, -1, 0, 0, 0, 0, 0, 0, 1.f, 3},
    {WS_YCAT, WS_W + 0ull * 32 * MiB + WO_WO * 2, 0, 1024, 1024, 1024, 256, 4, 1, 1, 0, 0, 0, 0, E_RESID0, 0, 1, -1, 0, 0, 0, 0, 0, 0, 1.f, 5},
    {WS_XH, WS_W + 0ull * 32 * MiB + WO_XWQ * 2, WS_XQ, 1024, 1024, 1024, 256, 4, 1, 1, 0, 0, 0, 0, E_F16, 1024, 0, -1, 1, 0, 0, 0 * NCS + 1792, 0, 0, XQSCALE, 7},
    {WS_XQ, WS_XK + 0 * 2048, WS_P, 1024, 2048, 256, 8, 1, 32, 4, SEQ * 1024, 256, 256 * 2048, 256, E_SOFTMAX, 0, 0, -1, 0, 0, 0, 0, 0, 0, 1.f, 8},
    {WS_P, WS_XVT + 0ull * 16 * MiB, WS_XO, 1024, MEMT, 256, 8, 1, 32, 4, SEQ * 1024, 256, 256, 256 * MEMT, E_F16, 1024, 0, -1, 0, 0, 0, 0, 0, 0, 1.f, 9},
    {WS_XO, WS_W + 0ull * 32 * MiB + WO_XWO * 2, 0, 1024, 1024, 1024, 256, 4, 1, 1, 0, 0, 0, 0, E_RESID, 0, 2, -1, 1, 0, 1, 0, 14, 0, 1.f, 10},
    {WS_XH, WS_W + 0ull * 32 * MiB + WO_FWIN * 2, WS_H, 1024, 1024, 1024, 256, 22, 1, 1, 0, 0, 0, 0, E_SWIGLU, 0, 0, -1, 1, 1, 0, 0 * NCS + 2816, 0, 0, 1.f, 12},
    {WS_H, WS_W + 0ull * 32 * MiB + WO_FWD * 2, 0, FFH, FFH, FFH, 256, 4, 1, 1, 0, 0, 0, 0, E_RESID, 0, 2, -1, 1, 1, 0, 0, 19, 0, 1.f, 13},
    {WS_XH, WS_W + 1ull * 32 * MiB + WO_WIN * 2, WS_PROJ, 1024, 1024, 1024, 256, 7, 1, 1, 0, 0, 0, 0, E_INPROJ, 0, 0, (int)WS_BIAS + 1 * 1792 * 4, 1, 0, 0, 1 * NCS, 0, 0, 1.f, 15},
    {WS_PROJ, WS_W + 1ull * 32 * MiB + WO_WUQ * 2, WS_Q, PROJW, 256, 256, 256, 3, 1, 1, 0, 0, 0, 0, E_QUP, 0, 0, -1, 0, 0, 0, 0, 0, 0, 1.f, 16},
    {WS_PROJ + 512, WS_W + 1ull * 32 * MiB + WO_WUK * 2, WS_KN, PROJW, 256, 256, 256, 2, 1, 1, 0, 0, 0, 0, E_KUP, 0, 0, -1, 0, 0, 0, 0, 0, 0, 1.f, 16},
    {WS_W + 1ull * 32 * MiB + WO_WUV * 2, WS_PROJ + 512, WS_VT, 256, PROJW, 256, 2, 256, 1, 1, 0, 0, 0, 0, E_VTUP, 0, 0, -1, 0, 0, 0, 0, 0, 0, 1.f, 16},
    {WS_YCAT, WS_W + 1ull * 32 * MiB + WO_WO * 2, 0, 1024, 1024, 1024, 256, 4, 1, 1, 0, 0, 0, 0, E_RESID, 0, 2, -1, 1, 0, 1, 0, 23, 0, 1.f, 18},
    {WS_XH, WS_W + 1ull * 32 * MiB + WO_XWQ * 2, WS_XQ, 1024, 1024, 1024, 256, 4, 1, 1, 0, 0, 0, 0, E_F16, 1024, 0, -1, 1, 1, 0, 1 * NCS + 1792, 0, 0, XQSCALE, 20},
    {WS_XQ, WS_XK + 1 * 2048, WS_P, 1024, 2048, 256, 8, 1, 32, 4, SEQ * 1024, 256, 256 * 2048, 256, E_SOFTMAX, 0, 0, -1, 0, 0, 0, 0, 0, 0, 1.f, 21},
    {WS_P, WS_XVT + 1ull * 16 * MiB, WS_XO, 1024, MEMT, 256, 8, 1, 32, 4, SEQ * 1024, 256, 256, 256 * MEMT, E_F16, 1024, 0, -1, 0, 0, 0, 0, 0, 0, 1.f, 22},
    {WS_XO, WS_W + 1ull * 32 * MiB + WO_XWO * 2, 0, 1024, 1024, 1024, 256, 4, 1, 1, 0, 0, 0, 0, E_RESID, 0, 2, -1, 1, 1, 0, 0, 14, 1, 1.f, 23},
    {WS_XH, WS_W + 1ull * 32 * MiB + WO_FWIN * 2, WS_H, 1024, 1024, 1024, 256, 22, 1, 1, 0, 0, 0, 0, E_SWIGLU, 0, 0, -1, 1, 0, 0, 1 * NCS + 2816, 0, 0, 1.f, 25},
    {WS_H, WS_W + 1ull * 32 * MiB + WO_FWD * 2, 0, FFH, FFH, FFH, 256, 4, 1, 1, 0, 0, 0, 0, E_RESID, 0, 2, -1, 1, 0, 1, 0, 19, 1, 1.f, 26},
    {0, 0, 0, 0, 0, 0, 0, 0, 0, 0, 0, 0, 0, 0, 0, 0, 0, 0, 0, 0, 0, 0, 0, 0, 0.f, 99},
};
__device__ __forceinline__ void load_gemm(GemmDesc& g, int ti, KP P) {
    const GT& t = GTAB[ti]; unsigned char* ws = P->ws;
    g.A = (const h16*)(ws + t.a); g.B = (const h16*)(ws + t.b); g.lda = t.lda; g.ldb = t.ldb; g.K = t.K; g.nM = t.nM; g.nN = t.nN; g.nZ1 = t.nZ1; g.nZ2 = t.nZ2;
    g.a_s1 = t.a_s1; g.a_s2 = t.a_s2; g.b_s1 = t.b_s1; g.b_s2 = t.b_s2; g.epi = t.epi; g.ldc = t.ldc; g.scale = t.scale; g.fold = t.fold;
    g.out = (void*)(ws + ((t.epi == E_RESID || t.epi == E_RESID0) ? WS_XH : t.o));
    g.st_in = (const float*)(ws + WS_ST) + (size_t)t.st_in * TT * 8; g.st_out = (float*)(ws + WS_ST) + (size_t)t.st_out * TT * 8;
    g.cs = (const float*)(ws + WS_CSBW) + t.cs;
    if (t.rkind == 1) { g.res = P->in[0]; g.bias = nullptr; }
    else if (t.rkind == 2) { g.res = P->in[t.gidx] + t.gl * DM; g.bias = P->in[t.gidx + 1] + t.gl * DM; }
    else { g.res = nullptr; g.bias = (const float*)(ws + (t.bias < 0 ? 0 : t.bias)); }
}

__global__ void __launch_bounds__(512, 2) fwd_megakernel(Params Pval) {
    extern __shared__ __attribute__((aligned(16))) unsigned char lds_raw[];
    LAS unsigned char* lds = (LAS unsigned char*)lds_raw;
    cg::grid_group grid = cg::this_grid();
    volatile LAS unsigned* bst = (volatile LAS unsigned*)(lds + 131072 + 8192 + 1024);
    if (threadIdx.x < 2) bst[threadIdx.x] = 0u;
    XcdBarrier xbar; xbar.bar = nullptr; xbar.x = 0; xbar.st = bst;
    int ti = 0;
    {
        KP P = kparams();
        if (bid_here() == 0) { unsigned* bw = (unsigned*)(P->ws + WS_BAR); for (int i = tid_here(); i < XCD_BAR_WORDS; i += 512) bw[i] = 0u; }
        prologue(lds, P);
        grid.sync();
        xbar = xcd_barrier_post((unsigned*)(P->ws + WS_BAR), bst);
    }
    for (int ph = 1; ph < 28; ++ph) {
        { const int sq = ph < 2 ? -1 : (ph - 2) % 13; if (ph == 2 || sq == 4 || sq == 9 || (sq == 12 && ph != 27)) continue; }
        KP P = kparams();
        {
            const int l = ph < 2 ? 0 : (ph - 2) / 13, s = ph < 2 ? -1 : (ph - 2) % 13;
            if (s == 1) conv_phase(lds, P, l);
            if (s == 2) attn_phase(lds, P);
            if (ph == 1) csbw_finalize(P);
            if (s == 12 && l == 1) ln_final(P, P->in[23] + DM, P->in[24] + DM);
            for (; GTAB[ti].ph == ph; ++ti) {
              {
                GemmDesc g; load_gemm(g, ti, P);
                unsigned char* ws = P->ws;
                __syncthreads();
                switch (g.epi) {
                case E_INPROJ: gemm_run<E_INPROJ>(lds, g, ws); break;
                case E_QUP: gemm_run<E_QUP>(lds, g, ws); break;
                case E_KUP: gemm_run<E_KUP>(lds, g, ws); break;
                case E_VTUP: gemm_run<E_VTUP>(lds, g, ws); break;
                case E_F16: gemm_run<E_F16>(lds, g, ws); break;
                case E_RESID: gemm_run<E_RESID>(lds, g, ws); break;
                case E_RESID0: gemm_run<E_RESID0>(lds, g, ws); break;
                case E_SOFTMAX: gemm_run<E_SOFTMAX>(lds, g, ws); break;
                default: gemm_run<E_SWIGLU>(lds, g, ws); break;
                }
                __syncthreads();
              }
            }
        }
        if (ph != 27) xcd_barrier(xbar);
    }
}

extern "C" void kernel_launch(void* const* d_in, const int* in_sizes, int n_in, void* d_out, int out_size, void* d_ws, size_t ws_size, hipStream_t stream) {
    static int grid_blocks = 0;
    if (!grid_blocks) {
        if (n_in != 25 || ws_size < WS_END) { fprintf(stderr, "kernel_launch: unexpected n_in %d / ws_size %zu\n", n_in, ws_size); grid_blocks = -1; return; }
        int dev = 0, cus = 0, per_cu = 0;
        hipGetDevice(&dev);
        hipDeviceGetAttribute(&cus, hipDeviceAttributeMultiprocessorCount, dev);
        if (hipFuncSetAttribute((const void*)fwd_megakernel, hipFuncAttributeMaxDynamicSharedMemorySize, LDS_BYTES) != hipSuccess) fprintf(stderr, "kernel_launch: hipFuncSetAttribute failed\n");
        hipOccupancyMaxActiveBlocksPerMultiprocessor(&per_cu, (const void*)fwd_megakernel, 512, LDS_BYTES);
        if (per_cu < 1) { fprintf(stderr, "kernel_launch: occupancy query gave %d\n", per_cu); per_cu = 1; }
        grid_blocks = cus * 1;
        (void)hipGetLastError();
    }
    if (grid_blocks < 0) return;
    Params p{};
    for (int i = 0; i < 25; ++i) p.in[i] = (const float*)d_in[i];
    p.pos = (const int*)d_in[2];
    p.out = (float*)d_out; p.ws = (unsigned char*)d_ws;
    void* args[] = {&p};
    hipError_t e = hipLaunchCooperativeKernel((const void*)fwd_megakernel, dim3(grid_blocks), dim3(512), args, LDS_BYTES, stream);
    if (e != hipSuccess) fprintf(stderr, "cooperative launch failed: %s (grid %d)\n", hipGetErrorString(e), grid_blocks);
}
```
